# Optimizing an MI355X kernel written in HIP

```python
import math
import jax
import jax.numpy as jnp
from jax import lax
import numpy as np


D_MODEL = 2048
BATCH = 2
SEQ = 16384
DEPTH = 2

N_A_LAYERS = DEPTH // 2
N_B_LAYERS = DEPTH - N_A_LAYERS
SSM_GROUP = 16
SSM_GROUPS = D_MODEL // SSM_GROUP
SSM_STATE = 64
SCAN_CHUNK = 128
HEAD_DIM = 128
N_HEADS = D_MODEL // HEAD_DIM
DILATION_CFG = ((128, 1), (512, 4), (2048, 16))
N_GROUPS = len(DILATION_CFG)
ATTN_BLOCK = 128
D_FF = -(-8 * D_MODEL // (3 * 256)) * 256
EPS = 1e-6

kernel_name = 'yoco_s5_dilated_window_hybrid'


def rmsnorm(x, g):
    xf = x.astype(jnp.float32)
    y = xf * lax.rsqrt(jnp.mean(xf * xf, axis=-1, keepdims=True) + EPS) * g.astype(jnp.float32)
    return y.astype(x.dtype)


def swiglu_ffn(h, w_gate_up, w_down):
    gate, up = jnp.split(h @ w_gate_up, 2, axis=-1)
    return (jax.nn.silu(gate) * up) @ w_down


def _complex_scan_combine(e1, e2):
    a1r, a1i, b1r, b1i = e1
    a2r, a2i, b2r, b2i = e2
    ar = a2r * a1r - a2i * a1i
    ai = a2r * a1i + a2i * a1r
    br = a2r * b1r - a2i * b1i + b2r
    bi = a2r * b1i + a2i * b1r + b2i
    return (ar, ai, br, bi)


def s5_mixer(u, a_re, a_im, log_dt, b_re, b_im, c_re, c_im, d_skip, w_glu):
    bsz, seqlen, _ = u.shape
    f32 = jnp.float32
    lam_re = jnp.minimum(a_re.astype(f32), -1e-4)
    lam_im = a_im.astype(f32)
    dt = jnp.exp(log_dt.astype(f32))[:, None]
    mag = jnp.exp(lam_re * dt)
    ang = lam_im * dt
    lb_re = mag * jnp.cos(ang)
    lb_im = mag * jnp.sin(ang)
    den = lam_re * lam_re + lam_im * lam_im
    nr = lb_re - 1.0
    ni = lb_im
    coef_re = (nr * lam_re + ni * lam_im) / den
    coef_im = (ni * lam_re - nr * lam_im) / den
    br = b_re.astype(f32)
    bi = b_im.astype(f32)
    bb_re = coef_re[..., None] * br - coef_im[..., None] * bi
    bb_im = coef_re[..., None] * bi + coef_im[..., None] * br
    cr = c_re.astype(f32)
    ci = c_im.astype(f32)
    a_shape = (bsz, SCAN_CHUNK, SSM_GROUPS, SSM_STATE)
    a_el_re = jnp.broadcast_to(lb_re, a_shape)
    a_el_im = jnp.broadcast_to(lb_im, a_shape)

    uf = u.astype(f32)
    n_chunks = seqlen // SCAN_CHUNK
    u_chunks = uf.reshape(bsz, n_chunks, SCAN_CHUNK, SSM_GROUPS, SSM_GROUP).transpose(1, 0, 2, 3, 4)

    def step(carry, u_c):
        h_re, h_im = carry
        bu_re = jnp.einsum('blgh,gph->blgp', u_c, bb_re)
        bu_im = jnp.einsum('blgh,gph->blgp', u_c, bb_im)
        ar, ai, sr, si = lax.associative_scan(_complex_scan_combine, (a_el_re, a_el_im, bu_re, bu_im), axis=1)
        st_re = ar * h_re[:, None] - ai * h_im[:, None] + sr
        st_im = ar * h_im[:, None] + ai * h_re[:, None] + si
        y = jnp.einsum('blgp,ghp->blgh', st_re, cr) - jnp.einsum('blgp,ghp->blgh', st_im, ci)
        return (st_re[:, -1], st_im[:, -1]), y

    h0 = (jnp.zeros((bsz, SSM_GROUPS, SSM_STATE), f32), jnp.zeros((bsz, SSM_GROUPS, SSM_STATE), f32))
    _, y = lax.scan(step, h0, u_chunks)
    y = y.transpose(1, 0, 2, 3, 4).reshape(bsz, seqlen, D_MODEL) + d_skip.astype(f32) * uf
    g = jax.nn.gelu(y).astype(u.dtype)
    val, gate = jnp.split(g @ w_glu, 2, axis=-1)
    return (val.astype(f32) * jax.nn.sigmoid(gate.astype(f32))).astype(u.dtype)


def alibi_slopes():
    n = N_GROUPS * N_HEADS
    i = jnp.arange(1, n + 1, dtype=jnp.float32)
    s = jnp.exp2(-8.0 * i / n)
    return s.reshape(N_HEADS, N_GROUPS).T


def head_rmsnorm(t, g):
    tf = t.astype(jnp.float32)
    y = tf * lax.rsqrt(jnp.mean(tf * tf, axis=-1, keepdims=True) + EPS) * g.astype(jnp.float32)
    return y.astype(t.dtype)


def shared_kv(x, kv_norm, w_kv, k_norm):
    bsz, seqlen, _ = x.shape
    kv = (rmsnorm(x, kv_norm) @ w_kv).reshape(bsz, seqlen, 2, N_HEADS, HEAD_DIM)
    k = head_rmsnorm(kv[:, :, 0], k_norm)
    v = kv[:, :, 1]
    return k, v


def dilated_window_group(q, k, v, window, dilation, slopes):
    bsz, seqlen, nh, dh = q.shape
    span = dilation * ATTN_BLOCK
    lp = -(-seqlen // span) * span
    pad = lp - seqlen
    n_sub = lp // dilation
    nb = n_sub // ATTN_BLOCK
    w_sub = window // dilation

    def to_blocks(t):
        t = jnp.pad(t, ((0, 0), (0, pad), (0, 0), (0, 0)))
        t = t.reshape(bsz, n_sub, dilation, nh, dh).transpose(0, 2, 1, 3, 4)
        return t.reshape(bsz, dilation, nb, ATTN_BLOCK, nh, dh)

    def with_prev(t):
        prev = jnp.pad(t[:, :, :-1], ((0, 0), (0, 0), (1, 0), (0, 0), (0, 0), (0, 0)))
        return jnp.concatenate([prev, t], axis=3)

    qb = to_blocks(q)
    kk = with_prev(to_blocks(k))
    vv = with_prev(to_blocks(v))
    s = jnp.einsum('bdnqhe,bdnkhe->bdnhqk', qb, kk, preferred_element_type=jnp.float32) * (dh ** -0.5)
    qi = jnp.arange(ATTN_BLOCK)[:, None] + ATTN_BLOCK
    kj = jnp.arange(2 * ATTN_BLOCK)[None, :]
    dist = qi - kj
    valid = (dist >= 0) & (dist <= w_sub)
    valid = valid[None] & ((jnp.arange(nb)[:, None, None] > 0) | (kj >= ATTN_BLOCK)[None])
    bias = -slopes[:, None, None] * (dilation * dist).astype(jnp.float32)[None]
    s = jnp.where(valid[:, None], s + bias, -jnp.inf)
    lse = jax.nn.logsumexp(s, axis=-1)
    p = jnp.exp(s - lse[..., None])
    o = jnp.einsum('bdnhqk,bdnkhe->bdnqhe', p.astype(v.dtype), vv, preferred_element_type=jnp.float32)
    o = o.reshape(bsz, dilation, n_sub, nh, dh).transpose(0, 2, 1, 3, 4).reshape(bsz, lp, nh, dh)[:, :seqlen]
    lse = lse.transpose(0, 1, 2, 4, 3).reshape(bsz, dilation, n_sub, nh)
    lse = lse.transpose(0, 2, 1, 3).reshape(bsz, lp, nh)[:, :seqlen]
    return o, lse


def dilated_attention(h, k, v, q_norm_l, w_q_l, w_o_l):
    bsz, seqlen, _ = h.shape
    q = (h @ w_q_l).reshape(bsz, seqlen, N_GROUPS, N_HEADS, HEAD_DIM)
    q = head_rmsnorm(q, q_norm_l[:, None, :])
    slopes = alibi_slopes()
    outs = []
    lses = []
    for g, (win, dil) in enumerate(DILATION_CFG):
        o, lse = dilated_window_group(q[:, :, g], k, v, win, dil, slopes[g])
        outs.append(o)
        lses.append(lse)
    wts = jax.nn.softmax(jnp.stack(lses, axis=0), axis=0)
    merged = jnp.sum(wts[..., None] * jnp.stack(outs, axis=0), axis=0)
    return merged.reshape(bsz, seqlen, N_HEADS * HEAD_DIM).astype(h.dtype) @ w_o_l


def setup_inputs(seed: int = 0) -> dict:
    key = jax.random.key(seed)
    ks = jax.random.split(key, 24)
    f32 = jnp.float32
    d = D_MODEL
    qkv_w = N_HEADS * HEAD_DIM
    nrm = lambda k, shape, scale: jax.random.normal(k, shape, f32) * scale
    n_idx = jnp.arange(SSM_STATE, dtype=f32)
    x = jax.random.normal(ks[0], (BATCH, SEQ, d), f32)
    mix_norm = 1.0 + nrm(ks[1], (DEPTH, d), 0.02)
    ffn_norm = 1.0 + nrm(ks[2], (DEPTH, d), 0.02)
    ssm_a_re = -0.5 + nrm(ks[3], (N_A_LAYERS, SSM_GROUPS, SSM_STATE), 0.01)
    ssm_a_im = math.pi * n_idx + nrm(ks[4], (N_A_LAYERS, SSM_GROUPS, SSM_STATE), 0.01)
    ssm_log_dt = jax.random.uniform(ks[5], (N_A_LAYERS, SSM_GROUPS), f32, math.log(1e-3), math.log(1e-1))
    ssm_b_re = nrm(ks[6], (N_A_LAYERS, SSM_GROUPS, SSM_STATE, SSM_GROUP), SSM_GROUP ** -0.5)
    ssm_b_im = nrm(ks[7], (N_A_LAYERS, SSM_GROUPS, SSM_STATE, SSM_GROUP), SSM_GROUP ** -0.5)
    ssm_c_re = nrm(ks[8], (N_A_LAYERS, SSM_GROUPS, SSM_GROUP, SSM_STATE), SSM_STATE ** -0.5)
    ssm_c_im = nrm(ks[9], (N_A_LAYERS, SSM_GROUPS, SSM_GROUP, SSM_STATE), SSM_STATE ** -0.5)
    ssm_d = nrm(ks[10], (N_A_LAYERS, d), 1.0)
    w_glu = nrm(ks[11], (N_A_LAYERS, d, 2 * d), d ** -0.5)
    kv_norm = 1.0 + nrm(ks[12], (d,), 0.02)
    w_kv = nrm(ks[13], (d, 2 * qkv_w), d ** -0.5)
    k_norm = 1.0 + nrm(ks[14], (HEAD_DIM,), 0.02)
    w_q = nrm(ks[15], (N_B_LAYERS, d, N_GROUPS * qkv_w), d ** -0.5)
    q_norm = 1.0 + nrm(ks[16], (N_B_LAYERS, N_GROUPS, HEAD_DIM), 0.02)
    w_o = nrm(ks[17], (N_B_LAYERS, qkv_w, d), qkv_w ** -0.5)
    w_gate_up = nrm(ks[18], (DEPTH, d, 2 * D_FF), d ** -0.5)
    w_down = nrm(ks[19], (DEPTH, D_FF, d), D_FF ** -0.5)
    return {'x': x, 'mix_norm': mix_norm, 'ffn_norm': ffn_norm,
            'ssm_a_re': ssm_a_re, 'ssm_a_im': ssm_a_im, 'ssm_log_dt': ssm_log_dt,
            'ssm_b_re': ssm_b_re, 'ssm_b_im': ssm_b_im, 'ssm_c_re': ssm_c_re, 'ssm_c_im': ssm_c_im,
            'ssm_d': ssm_d, 'w_glu': w_glu, 'kv_norm': kv_norm, 'w_kv': w_kv, 'k_norm': k_norm,
            'w_q': w_q, 'q_norm': q_norm, 'w_o': w_o, 'w_gate_up': w_gate_up, 'w_down': w_down}


def reference(x, mix_norm, ffn_norm, ssm_a_re, ssm_a_im, ssm_log_dt, ssm_b_re, ssm_b_im, ssm_c_re, ssm_c_im,
              ssm_d, w_glu, kv_norm, w_kv, k_norm, w_q, q_norm, w_o, w_gate_up, w_down):
    k = None
    v = None
    for layer in range(DEPTH):
        h = rmsnorm(x, mix_norm[layer])
        if layer < N_A_LAYERS:
            i = layer
            x = x + s5_mixer(h, ssm_a_re[i], ssm_a_im[i], ssm_log_dt[i], ssm_b_re[i], ssm_b_im[i],
                             ssm_c_re[i], ssm_c_im[i], ssm_d[i], w_glu[i])
        else:
            if layer == N_A_LAYERS:
                k, v = shared_kv(x, kv_norm, w_kv, k_norm)
            j = layer - N_A_LAYERS
            x = x + dilated_attention(h, k, v, q_norm[j], w_q[j], w_o[j])
        x = x + swiglu_ffn(rmsnorm(x, ffn_norm[layer]), w_gate_up[layer], w_down[layer])
    return x
```

```cpp
#include <hip/hip_runtime.h>
#include <hip/hip_cooperative_groups.h>
#include <cstdio>
#include <cstdint>
#include <cmath>
namespace cg = cooperative_groups;
namespace pg8 {
#define PG8_LAS __attribute__((address_space(3)))
typedef unsigned short bf16_t;
typedef short bf16x8 __attribute__((ext_vector_type(8)));
typedef float f32x4 __attribute__((ext_vector_type(4)));
typedef unsigned u32x4 __attribute__((ext_vector_type(4)));
constexpr int BM = 256, BK = 64, HALF = 128, HTB = HALF * BK * 2  , STAGE_BYTES = 8 * HTB, NXCD = 8, WGM = 4;

__host__ __device__ __forceinline__ int lds_byte(int r, int c) { const int st = (r >> 4) * 2 + (c >> 5), rr = r & 15, cc = c & 31, ob = rr * 64 + cc * 2; return st * 1024 + (ob ^ (((ob >> 9) & 1) << 5)); }
__host__ __device__ __forceinline__ void stage_rc(int b, int& R, int& C) { const int st = b / 1024, sb = b % 1024, swz = sb ^ (((sb >> 9) & 1) << 5); R = (st >> 1) * 16 + swz / 64; C = (st & 1) * 32 + (swz % 64) / 2; }
__host__ __device__ __forceinline__ int perm32(int rho) { const int n = rho >> 4, i = rho & 15; return 8 * (i >> 2) + 4 * n + (i & 3); }

struct Unit { int pm, pn; };
struct Gemm { const bf16_t* A; const bf16_t* Bt; int M, N, K; };

struct StaticOrder {
    int nM, nN, nwg, G, c;
    __host__ __device__ void init(int M, int N, int G_, int c_) { nM = M / BM; nN = N / BM; nwg = nM * nN; G = G_; c = c_; }
    __host__ __device__ bool next(int i, Unit& u) const {
        const long L = (long)i * G + c; if (L >= nwg) return false;
        int wgid = (int)L; { const int q = nwg / NXCD, r = nwg % NXCD, xcd = wgid % NXCD, off = wgid / NXCD; wgid = (xcd < r ? xcd * (q + 1) : r * (q + 1) + (xcd - r) * q) + off; }
        const int nig = WGM * nN, gid = wgid / nig, fm = gid * WGM, gsz = (nM - fm) < WGM ? (nM - fm) : WGM;
        u.pm = fm + ((wgid % nig) % gsz); u.pn = (wgid % nig) / gsz; return true;
    }
    __device__ __forceinline__ void a_ready(const Unit&) const {}
    __device__ __forceinline__ void done(const Unit&) const {}
};

__device__ __forceinline__ unsigned cvt_pk_bf16(float lo, float hi) { unsigned r; asm volatile("v_cvt_pk_bf16_f32 %0, %1, %2" : "=v"(r) : "v"(lo), "v"(hi)); return r; }
typedef float f32x2 __attribute__((ext_vector_type(2)));
__device__ __forceinline__ f32x2 gelu_pk(f32x2 v) {
    const f32x2 av = __builtin_elementwise_abs(v), d = av * 0.2316418882f + 1.0f;
    f32x2 t; t.x = __builtin_amdgcn_rcpf(d.x); t.y = __builtin_amdgcn_rcpf(d.y);
    f32x2 q = t * 0.5307027145f + (-0.7265760135f); q = q * t + 0.7107068705f; q = q * t + (-0.142248368f); q = q * t + 0.127414796f; q = q * t;
    const f32x2 s = (v * v) * (-0.72134752044f);
    f32x2 e; e.x = __builtin_amdgcn_exp2f(s.x); e.y = __builtin_amdgcn_exp2f(s.y);
    const f32x2 m = v * (q * e), r = v - m;
    f32x2 o; o.x = v.x < 0.f ? m.x : r.x; o.y = v.y < 0.f ? m.y : r.y; return o;
}

template <int ACT  > struct EpiBf16 {
    static constexpr bool PERM = true, AFTER_DRAIN = false; static_assert(ACT == 0 || ACT == 1, "EpiBf16: ACT is 0 (none) or 1 (gelu_pk)");
    bf16_t* O; int ldc; const float* bias; int split_cols; size_t split_stride; float scale0;
    __device__ __forceinline__ void operator()(const f32x4 (&acc)[2][2][4][2], const Unit& u, int wr, int wc, int fr, int fq) const {
        const int row0 = u.pm * BM + wr * 64 + fr; int colt = u.pn * BM; bf16_t* base = O;
        float sc = 1.f; if (split_cols) { const int t = colt / split_cols; base += (size_t)t * split_stride; colt -= t * split_cols; if (t == 0) sc = scale0; }
        const int col0 = colt + wc * 32 + 8 * fq, bcol0 = u.pn * BM + wc * 32 + 8 * fq;
        f32x4 bv[2][2];
#pragma unroll
        for (int bj = 0; bj < 2; ++bj)
#pragma unroll
            for (int n = 0; n < 2; ++n) bv[bj][n] = bias ? *(const f32x4*)(bias + bcol0 + bj * HALF + 4 * n) : (f32x4){0.f, 0.f, 0.f, 0.f};
#pragma unroll
        for (int ai = 0; ai < 2; ++ai)
#pragma unroll
            for (int m = 0; m < 4; ++m) { bf16_t* rowp = base + (size_t)(row0 + ai * HALF + m * 16) * ldc + col0;
#pragma unroll
                for (int bj = 0; bj < 2; ++bj) { f32x4 v0 = acc[ai][bj][m][0] + bv[bj][0], v1 = acc[ai][bj][m][1] + bv[bj][1];
                    if (ACT == 1) { f32x2 a = gelu_pk((f32x2){v0[0], v0[1]}), b = gelu_pk((f32x2){v0[2], v0[3]}), c = gelu_pk((f32x2){v1[0], v1[1]}), d = gelu_pk((f32x2){v1[2], v1[3]});
                        v0 = (f32x4){a.x, a.y, b.x, b.y}; v1 = (f32x4){c.x, c.y, d.x, d.y}; }
                    v0 = v0 * sc; v1 = v1 * sc; u32x4 w; w.x = cvt_pk_bf16(v0[0], v0[1]); w.y = cvt_pk_bf16(v0[2], v0[3]); w.z = cvt_pk_bf16(v1[0], v1[1]); w.w = cvt_pk_bf16(v1[2], v1[3]);
                    *(u32x4*)(rowp + bj * HALF) = w; } }
    }
};
typedef unsigned u32x2e __attribute__((ext_vector_type(2)));
__device__ __forceinline__ float sigmoid_f(float x) { return __builtin_amdgcn_rcpf(1.0f + __builtin_amdgcn_exp2f(-1.4426950408889634f * x)); }
struct EpiGluRes {
    static constexpr bool PERM = true, AFTER_DRAIN = false;
    const float* resid; float* out; int ldc;
    __device__ __forceinline__ void operator()(const f32x4 (&acc)[2][2][4][2], const Unit& u, int wr, int wc, int fr, int fq) const {
        const int row0 = u.pm * BM + wr * 64 + fr, col0 = u.pn * HALF + wc * 32 + 8 * fq;
#pragma unroll
        for (int ai = 0; ai < 2; ++ai)
#pragma unroll
            for (int m = 0; m < 4; ++m) { const size_t off = (size_t)(row0 + ai * HALF + m * 16) * ldc + col0;
#pragma unroll
                for (int n = 0; n < 2; ++n) { const f32x4 r = *(const f32x4*)(resid + off + 4 * n); const f32x4 v = acc[ai][0][m][n], g = acc[ai][1][m][n]; f32x4 o;
                    o[0] = r[0] + v[0] * sigmoid_f(g[0]); o[1] = r[1] + v[1] * sigmoid_f(g[1]); o[2] = r[2] + v[2] * sigmoid_f(g[2]); o[3] = r[3] + v[3] * sigmoid_f(g[3]);
                    *(f32x4*)(out + off + 4 * n) = o; } }
    }
};
struct EpiSwiglu {
    static constexpr bool PERM = true, AFTER_DRAIN = false;
    bf16_t* O; int ldc;
    __device__ __forceinline__ void operator()(const f32x4 (&acc)[2][2][4][2], const Unit& u, int wr, int wc, int fr, int fq) const {
        const int row0 = u.pm * BM + wr * 64 + fr, col0 = u.pn * HALF + wc * 32 + 8 * fq;
#pragma unroll
        for (int ai = 0; ai < 2; ++ai)
#pragma unroll
            for (int m = 0; m < 4; ++m) { bf16_t* rowp = O + (size_t)(row0 + ai * HALF + m * 16) * ldc + col0;
                float h[8];
#pragma unroll
                for (int n = 0; n < 2; ++n)
#pragma unroll
                    for (int e = 0; e < 4; ++e) { const float g = acc[ai][0][m][n][e], up = acc[ai][1][m][n][e]; h[4 * n + e] = g * sigmoid_f(g) * up; }
                u32x4 w; w.x = cvt_pk_bf16(h[0], h[1]); w.y = cvt_pk_bf16(h[2], h[3]); w.z = cvt_pk_bf16(h[4], h[5]); w.w = cvt_pk_bf16(h[6], h[7]);
                *(u32x4*)rowp = w; }
    }
};
struct EpiResAdd {
    static constexpr bool PERM = true, AFTER_DRAIN = false;
    const float* resid; float* out; int ldc;
    __device__ __forceinline__ void operator()(const f32x4 (&acc)[2][2][4][2], const Unit& u, int wr, int wc, int fr, int fq) const {
        const int row0 = u.pm * BM + wr * 64 + fr, col0 = u.pn * BM + wc * 32 + 8 * fq;
#pragma unroll
        for (int ai = 0; ai < 2; ++ai)
#pragma unroll
            for (int m = 0; m < 4; ++m) { const size_t off = (size_t)(row0 + ai * HALF + m * 16) * ldc + col0;
#pragma unroll
                for (int bj = 0; bj < 2; ++bj)
#pragma unroll
                    for (int n = 0; n < 2; ++n) { const f32x4 r = *(const f32x4*)(resid + off + bj * HALF + 4 * n); *(f32x4*)(out + off + bj * HALF + 4 * n) = r + acc[ai][bj][m][n]; } }
    }
};

__device__ __forceinline__ float bfl(unsigned w) { return __builtin_bit_cast(float, w << 16); }
__device__ __forceinline__ float bfh(unsigned w) { return __builtin_bit_cast(float, w & 0xffff0000u); }
__device__ __forceinline__ void ss_add(float* ss, int row, float s, int fq) {
    s += __shfl_xor(s, 16); s += __shfl_xor(s, 32);
    if (fq == 0) __hip_atomic_fetch_add(ss + row, s, __ATOMIC_RELAXED, __HIP_MEMORY_SCOPE_AGENT);
}
struct EpiGluRes2 {
    static constexpr bool PERM = true, AFTER_DRAIN = false;
    const float* resid; bf16_t* out; float* ss; int ldc;
    __device__ __forceinline__ void operator()(const f32x4 (&acc)[2][2][4][2], const Unit& u, int wr, int wc, int fr, int fq) const {
        const int row0 = u.pm * BM + wr * 64 + fr, col0 = u.pn * HALF + wc * 32 + 8 * fq;
#pragma unroll
        for (int ai = 0; ai < 2; ++ai)
#pragma unroll
            for (int m = 0; m < 4; ++m) { const int row = row0 + ai * HALF + m * 16; const size_t off = (size_t)row * ldc + col0; float o[8]; float s = 0.f;
#pragma unroll
                for (int n = 0; n < 2; ++n) { const f32x4 r = *(const f32x4*)(resid + off + 4 * n); const f32x4 v = acc[ai][0][m][n], g = acc[ai][1][m][n];
#pragma unroll
                    for (int e = 0; e < 4; ++e) { const float x = r[e] + v[e] * sigmoid_f(g[e]); o[4 * n + e] = x; s += x * x; } }
                u32x4 w; w.x = cvt_pk_bf16(o[0], o[1]); w.y = cvt_pk_bf16(o[2], o[3]); w.z = cvt_pk_bf16(o[4], o[5]); w.w = cvt_pk_bf16(o[6], o[7]);
                *(u32x4*)(out + off) = w; ss_add(ss, row, s, fq); }
    }
};
struct EpiResAddBf {
    static constexpr bool PERM = true, AFTER_DRAIN = false;
    const bf16_t* resid; bf16_t* out; float* ss; int ldc;
    __device__ __forceinline__ void operator()(const f32x4 (&acc)[2][2][4][2], const Unit& u, int wr, int wc, int fr, int fq) const {
        const int row0 = u.pm * BM + wr * 64 + fr, col0 = u.pn * BM + wc * 32 + 8 * fq;
#pragma unroll
        for (int ai = 0; ai < 2; ++ai)
#pragma unroll
            for (int m = 0; m < 4; ++m) { const int row = row0 + ai * HALF + m * 16; const size_t off = (size_t)row * ldc + col0; float s = 0.f;
#pragma unroll
                for (int bj = 0; bj < 2; ++bj) { const u32x4 r = *(const u32x4*)(resid + off + bj * HALF); const f32x4 a0 = acc[ai][bj][m][0], a1 = acc[ai][bj][m][1];
                    const float o0 = bfl(r.x) + a0[0], o1 = bfh(r.x) + a0[1], o2 = bfl(r.y) + a0[2], o3 = bfh(r.y) + a0[3], o4 = bfl(r.z) + a1[0], o5 = bfh(r.z) + a1[1], o6 = bfl(r.w) + a1[2], o7 = bfh(r.w) + a1[3];
                    s += (o0 * o0 + o1 * o1) + (o2 * o2 + o3 * o3) + (o4 * o4 + o5 * o5) + (o6 * o6 + o7 * o7);
                    u32x4 w; w.x = cvt_pk_bf16(o0, o1); w.y = cvt_pk_bf16(o2, o3); w.z = cvt_pk_bf16(o4, o5); w.w = cvt_pk_bf16(o6, o7);
                    *(u32x4*)(out + off + bj * HALF) = w; }
                ss_add(ss, row, s, fq); }
    }
};
struct EpiResAddF32 {
    static constexpr bool PERM = true, AFTER_DRAIN = false;
    const bf16_t* resid; float* out; int ldc;
    __device__ __forceinline__ void operator()(const f32x4 (&acc)[2][2][4][2], const Unit& u, int wr, int wc, int fr, int fq) const {
        const int row0 = u.pm * BM + wr * 64 + fr, col0 = u.pn * BM + wc * 32 + 8 * fq;
#pragma unroll
        for (int ai = 0; ai < 2; ++ai)
#pragma unroll
            for (int m = 0; m < 4; ++m) { const size_t off = (size_t)(row0 + ai * HALF + m * 16) * ldc + col0;
#pragma unroll
                for (int bj = 0; bj < 2; ++bj) { const u32x4 r = *(const u32x4*)(resid + off + bj * HALF); const f32x4 a0 = acc[ai][bj][m][0], a1 = acc[ai][bj][m][1];
                    *(f32x4*)(out + off + bj * HALF) = (f32x4){bfl(r.x) + a0[0], bfh(r.x) + a0[1], bfl(r.y) + a0[2], bfh(r.y) + a0[3]};
                    *(f32x4*)(out + off + bj * HALF + 4) = (f32x4){bfl(r.z) + a1[0], bfh(r.z) + a1[1], bfl(r.w) + a1[2], bfh(r.w) + a1[3]}; } }
    }
};
struct EpiSwiglu2 {
    static constexpr bool PERM = true, AFTER_DRAIN = false;
    bf16_t* O; int ldc; const float* ss; float inv_n, eps;
    __device__ __forceinline__ void operator()(const f32x4 (&acc)[2][2][4][2], const Unit& u, int wr, int wc, int fr, int fq) const {
        const int row0 = u.pm * BM + wr * 64 + fr, col0 = u.pn * HALF + wc * 32 + 8 * fq;
#pragma unroll
        for (int ai = 0; ai < 2; ++ai)
#pragma unroll
            for (int m = 0; m < 4; ++m) { const int row = row0 + ai * HALF + m * 16; bf16_t* rowp = O + (size_t)row * ldc + col0; const float rs = __builtin_amdgcn_rsqf(ss[row] * inv_n + eps);
                float h[8];
#pragma unroll
                for (int n = 0; n < 2; ++n)
#pragma unroll
                    for (int e = 0; e < 4; ++e) { const float g = acc[ai][0][m][n][e] * rs, up = acc[ai][1][m][n][e] * rs; h[4 * n + e] = g * sigmoid_f(g) * up; }
                u32x4 w; w.x = cvt_pk_bf16(h[0], h[1]); w.y = cvt_pk_bf16(h[2], h[3]); w.z = cvt_pk_bf16(h[4], h[5]); w.w = cvt_pk_bf16(h[6], h[7]);
                *(u32x4*)rowp = w; }
    }
};

struct EpiQKV {
    static constexpr bool PERM = true, AFTER_DRAIN = false;
    bf16_t* base; size_t tstride; int seq, pitch; const float* ss; float inv_n, eps; PG8_LAS float* kscr; const float* kgain;
    __device__ __forceinline__ void operator()(const f32x4 (&acc)[2][2][4][2], const Unit& u, int wr, int wc, int fr, int fq) const {
        const int colt = u.pn * BM, t = colt >> 11, head0 = (colt & 2047) >> 7, d = wc * 32 + 8 * fq;
        const int rowt = u.pm * BM, b = rowt / seq, tok0 = rowt - b * seq + wr * 64 + fr;
        bf16_t* tb = base + (size_t)t * tstride;
        const bool isk = (t == 3);
        float rs[2][4];
#pragma unroll
        for (int ai = 0; ai < 2; ++ai)
#pragma unroll
            for (int m = 0; m < 4; ++m) rs[ai][m] = __builtin_amdgcn_rsqf(ss[rowt + wr * 64 + fr + ai * HALF + m * 16] * inv_n + eps);
        f32x4 kg0 = {1.f, 1.f, 1.f, 1.f}, kg1 = {1.f, 1.f, 1.f, 1.f};
        if (isk) {
            kg0 = *(const f32x4*)(kgain + d); kg1 = *(const f32x4*)(kgain + d + 4);
#pragma unroll
            for (int bj = 0; bj < 2; ++bj)
#pragma unroll
                for (int ai = 0; ai < 2; ++ai)
#pragma unroll
                    for (int m = 0; m < 4; ++m) { const f32x4 v0 = acc[ai][bj][m][0] * rs[ai][m], v1 = acc[ai][bj][m][1] * rs[ai][m];
                        float s = (v0[0] * v0[0] + v0[1] * v0[1]) + (v0[2] * v0[2] + v0[3] * v0[3]) + (v1[0] * v1[0] + v1[1] * v1[1]) + (v1[2] * v1[2] + v1[3] * v1[3]);
                        s += __shfl_xor(s, 16); s += __shfl_xor(s, 32);
                        if (fq == 0) kscr[((ai * HALF + wr * 64 + m * 16 + fr) * 2 + bj) * 4 + wc] = s; }
            asm volatile("s_waitcnt lgkmcnt(0)" ::: "memory"); __builtin_amdgcn_s_barrier(); asm volatile("" ::: "memory");
        }
#pragma unroll
        for (int bj = 0; bj < 2; ++bj) { bf16_t* hb = tb + ((size_t)(b * 16 + head0 + bj) * seq) * pitch + d;
#pragma unroll
            for (int ai = 0; ai < 2; ++ai)
#pragma unroll
                for (int m = 0; m < 4; ++m) { float sc = rs[ai][m];
                    if (isk) { const f32x4 p = *(const PG8_LAS f32x4*)(kscr + ((ai * HALF + wr * 64 + m * 16 + fr) * 2 + bj) * 4); sc *= __builtin_amdgcn_rsqf(((p[0] + p[1]) + (p[2] + p[3])) * (1.0f / 128.0f) + eps); }
                    const f32x4 v0 = acc[ai][bj][m][0] * sc * kg0, v1 = acc[ai][bj][m][1] * sc * kg1;
                    u32x4 w; w.x = cvt_pk_bf16(v0[0], v0[1]); w.y = cvt_pk_bf16(v0[2], v0[3]); w.z = cvt_pk_bf16(v1[0], v1[1]); w.w = cvt_pk_bf16(v1[2], v1[3]);
                    *(u32x4*)(hb + (size_t)(tok0 + ai * HALF + m * 16) * pitch) = w; } }
    }
};
template <class Epi, class Sched, bool ALIGN_EPI = false, bool SP2 = false>
__device__ __forceinline__ void gemm_phase(PG8_LAS unsigned char* lds, const Gemm g, const Sched& S, const Epi& E) {
    int tid_ = threadIdx.x; asm volatile("" : "+v"(tid_));
    const int tid = tid_, wid = __builtin_amdgcn_readfirstlane(tid >> 6), lane = tid & 63, wr = wid >> 2, wc = wid & 3, fr = lane & 15, fq = lane >> 4;
    const int K = g.K, nt = K / BK;
    unsigned voffA[2], voffB[2];
#pragma unroll
    for (int i = 0; i < 2; ++i) { int R, C; stage_rc(tid * 16 + i * 8192, R, C); const int Rb = Epi::PERM ? ((R & ~31) + perm32(R & 31)) : R;
        voffA[i] = (unsigned)(R * K + C) * 2u; voffB[i] = (unsigned)(Rb * K + C) * 2u; }
    const size_t kstep = (size_t)(BK * 2);
    const size_t hstep = (size_t)HALF * K * 2;
    const size_t tstep = 2 * hstep;
    const unsigned ldsw = (unsigned)wid * 1024u;
    const int aoff = lds_byte(wr * 64 + fr, fq * 8), boff = lds_byte(wc * 32 + fr, fq * 8);
#define PG8_SA(b, h) (((b) * 2 + (h)) * HTB)
#define PG8_SB(b, h) ((4 + (b) * 2 + (h)) * HTB)
#define PG8_STAGE(bufoff, gbase, voff) do { _Pragma("unroll") for (int _i = 0; _i < 2; ++_i) \
        __builtin_amdgcn_global_load_lds((const unsigned*)((const char*)(gbase) + (voff)[_i]), (PG8_LAS unsigned*)(lds + (bufoff) + ldsw + _i * 8192), 16, 0, 0); } while (0)
#define PG8_LDA(dst, b, h) do { _Pragma("unroll") for (int m = 0; m < 4; ++m) _Pragma("unroll") for (int k = 0; k < 2; ++k) dst[m][k] = *(const PG8_LAS bf16x8*)(lds + PG8_SA(b, h) + aoff + m * 2048 + k * 1024); } while (0)
#define PG8_LDB(dst, b, h) do { _Pragma("unroll") for (int n = 0; n < 2; ++n) _Pragma("unroll") for (int k = 0; k < 2; ++k) dst[n][k] = *(const PG8_LAS bf16x8*)(lds + PG8_SB(b, h) + boff + n * 2048 + k * 1024); } while (0)
#define PG8_MMA(ai, bj, At, Bt) do { __builtin_amdgcn_s_setprio(1); _Pragma("unroll") for (int m = 0; m < 4; ++m) _Pragma("unroll") for (int n = 0; n < 2; ++n) _Pragma("unroll") for (int k = 0; k < 2; ++k) \
        acc[ai][bj][m][n] = __builtin_amdgcn_mfma_f32_16x16x32_bf16(Bt[n][k], At[m][k], acc[ai][bj][m][n], 0, 0, 0); __builtin_amdgcn_s_setprio(0); } while (0)
#define PG8_WAIT_V(n) asm volatile("s_waitcnt vmcnt(" #n ")" ::: "memory")
#define PG8_WAIT_L(n) asm volatile("s_waitcnt lgkmcnt(" #n ")" ::: "memory")
#define PG8_BAR __builtin_amdgcn_s_barrier()
#define PG8_SCHED __builtin_amdgcn_sched_barrier(0)
    Unit cur, nxt; int ui = 0;
    if (!S.next(0, cur)) return;
    f32x4 acc[2][2][4][2];
#pragma unroll
    for (int a = 0; a < 2; ++a)
#pragma unroll
        for (int b = 0; b < 2; ++b)
#pragma unroll
            for (int m = 0; m < 4; ++m)
#pragma unroll
                for (int n = 0; n < 2; ++n) acc[a][b][m][n] = (f32x4){0.f, 0.f, 0.f, 0.f};
    bf16x8 At[4][2], B0[2][2], B1[2][2];
    const char* cA = (const char*)g.A + (size_t)cur.pm * tstep; const char* cB = (const char*)g.Bt + (size_t)cur.pn * tstep;
    S.a_ready(cur);
    if constexpr (SP2) {
        PG8_STAGE(PG8_SB(0, 0), cB, voffB); PG8_STAGE(PG8_SB(0, 1), cB + hstep, voffB); PG8_STAGE(PG8_SA(0, 0), cA, voffA); PG8_STAGE(PG8_SA(0, 1), cA + hstep, voffA);
        if (wr == 1) PG8_BAR;
        PG8_WAIT_V(2); PG8_BAR;
        PG8_STAGE(PG8_SB(1, 0), cB + kstep, voffB); PG8_STAGE(PG8_SA(1, 0), cA + kstep, voffA); PG8_STAGE(PG8_SB(1, 1), cB + hstep + kstep, voffB);
        PG8_WAIT_V(6); PG8_BAR;
    } else {
        PG8_STAGE(PG8_SB(0, 0), cB, voffB); PG8_STAGE(PG8_SA(0, 0), cA, voffA); PG8_STAGE(PG8_SB(0, 1), cB + hstep, voffB); PG8_STAGE(PG8_SA(0, 1), cA + hstep, voffA);
        if (wr == 1) PG8_BAR;
        PG8_WAIT_V(4); PG8_BAR;
        PG8_STAGE(PG8_SB(1, 0), cB + kstep, voffB); PG8_STAGE(PG8_SA(1, 0), cA + kstep, voffA); PG8_STAGE(PG8_SB(1, 1), cB + hstep + kstep, voffB);
        PG8_WAIT_V(6); PG8_BAR;
    }
    for (;;) {
        const bool has_next = S.next(ui + 1, nxt);
        const char* nA = has_next ? (const char*)g.A + (size_t)nxt.pm * tstep : cA; const char* nB = has_next ? (const char*)g.Bt + (size_t)nxt.pn * tstep : cB;
        for (int t = 0; t < nt; t += 2) {
            const bool last = (t == nt - 2);
            const char* a1 = cA + (size_t)(t + 1) * kstep;
            const char* a2 = last ? nA : cA + (size_t)(t + 2) * kstep; const char* b2 = last ? nB : cB + (size_t)(t + 2) * kstep;
            const char* a3 = a2 + kstep; const char* b3 = b2 + kstep;
            if (last && has_next) S.a_ready(nxt);
            if constexpr (SP2) {
            PG8_LDB(B0, 0, 0); PG8_LDB(B1, 0, 1); PG8_SCHED; PG8_LDA(At, 0, 0); PG8_STAGE(PG8_SA(1, 1), a1 + hstep, voffA);
            PG8_WAIT_V(8); PG8_WAIT_L(0); PG8_BAR; PG8_MMA(0, 0, At, B0); PG8_MMA(0, 1, At, B1); PG8_BAR; PG8_SCHED;
            PG8_LDA(At, 0, 1); PG8_STAGE(PG8_SB(0, 0), b2, voffB); PG8_STAGE(PG8_SB(0, 1), b2 + hstep, voffB); PG8_STAGE(PG8_SA(0, 0), a2, voffA);
            PG8_WAIT_V(8); PG8_WAIT_L(0); PG8_BAR; PG8_MMA(1, 0, At, B0); PG8_MMA(1, 1, At, B1); PG8_BAR; PG8_SCHED;
            PG8_LDB(B0, 1, 0); PG8_LDB(B1, 1, 1); PG8_SCHED; PG8_LDA(At, 1, 0); PG8_STAGE(PG8_SA(0, 1), a2 + hstep, voffA);
            PG8_WAIT_V(8); PG8_WAIT_L(0); PG8_BAR; PG8_MMA(0, 0, At, B0); PG8_MMA(0, 1, At, B1); PG8_BAR; PG8_SCHED;
            PG8_LDA(At, 1, 1); PG8_STAGE(PG8_SB(1, 0), b3, voffB); PG8_STAGE(PG8_SB(1, 1), b3 + hstep, voffB); PG8_STAGE(PG8_SA(1, 0), a3, voffA);
            PG8_WAIT_V(8); PG8_WAIT_L(0); PG8_BAR; PG8_MMA(1, 0, At, B0); PG8_MMA(1, 1, At, B1); PG8_BAR; PG8_SCHED;
            } else {
            PG8_LDB(B0, 0, 0); PG8_SCHED; PG8_LDA(At, 0, 0); PG8_STAGE(PG8_SA(1, 1), a1 + hstep, voffA);
            PG8_WAIT_L(8); PG8_BAR; PG8_WAIT_L(0); PG8_MMA(0, 0, At, B0); PG8_BAR; PG8_SCHED;
            PG8_LDB(B1, 0, 1); PG8_STAGE(PG8_SB(0, 0), b2, voffB);
            PG8_BAR; PG8_WAIT_L(0); PG8_MMA(0, 1, At, B1); PG8_BAR;
            PG8_LDA(At, 0, 1); PG8_STAGE(PG8_SA(0, 0), a2, voffA);
            PG8_BAR; PG8_WAIT_L(0); PG8_MMA(1, 0, At, B0); PG8_BAR; PG8_SCHED;
            PG8_STAGE(PG8_SB(0, 1), b2 + hstep, voffB);
            PG8_WAIT_V(6); PG8_BAR; PG8_MMA(1, 1, At, B1); PG8_BAR;
            PG8_LDB(B0, 1, 0); PG8_SCHED; PG8_LDA(At, 1, 0); PG8_STAGE(PG8_SA(0, 1), a2 + hstep, voffA);
            PG8_WAIT_L(8); PG8_BAR; PG8_WAIT_L(0); PG8_MMA(0, 0, At, B0); PG8_BAR; PG8_SCHED;
            PG8_LDB(B1, 1, 1); PG8_STAGE(PG8_SB(1, 0), b3, voffB);
            PG8_BAR; PG8_WAIT_L(0); PG8_MMA(0, 1, At, B1); PG8_BAR;
            PG8_LDA(At, 1, 1); PG8_STAGE(PG8_SA(1, 0), a3, voffA);
            PG8_BAR; PG8_WAIT_L(0); PG8_MMA(1, 0, At, B0); PG8_BAR; PG8_SCHED;
            PG8_STAGE(PG8_SB(1, 1), b3 + hstep, voffB);
            PG8_WAIT_V(6); PG8_BAR; PG8_MMA(1, 1, At, B1); PG8_BAR;
            }
        }
        if constexpr (ALIGN_EPI) { if (wr == 0) PG8_BAR; }
        if constexpr (!Epi::AFTER_DRAIN) { E(acc, cur, wr, wc, fr, fq); S.done(cur); }
        if (!has_next) break;
#pragma unroll
        for (int a = 0; a < 2; ++a)
#pragma unroll
            for (int b = 0; b < 2; ++b)
#pragma unroll
                for (int m = 0; m < 4; ++m)
#pragma unroll
                    for (int n = 0; n < 2; ++n) acc[a][b][m][n] = (f32x4){0.f, 0.f, 0.f, 0.f};
        cur = nxt; cA = nA; cB = nB; ++ui;
        if constexpr (ALIGN_EPI) { if (wr == 1) PG8_BAR; }
    }
    PG8_WAIT_V(0);
    if constexpr (!ALIGN_EPI) { if (wr == 0) PG8_BAR; }
    PG8_BAR;
    if constexpr (Epi::AFTER_DRAIN) { E.fused(acc, cur, wr, wc, fr, fq, lds, wid, lane); S.done(cur); }
#undef PG8_SA
#undef PG8_SB
#undef PG8_STAGE
#undef PG8_LDA
#undef PG8_LDB
#undef PG8_MMA
#undef PG8_WAIT_V
#undef PG8_WAIT_L
#undef PG8_BAR
#undef PG8_SCHED
}
}

#define LAS __attribute__((address_space(3)))
typedef unsigned short bf16_t;
typedef short bf16x8 __attribute__((ext_vector_type(8)));
typedef short s16x4 __attribute__((ext_vector_type(4)));
typedef float f32x4 __attribute__((ext_vector_type(4)));
typedef float f32x16 __attribute__((ext_vector_type(16)));
typedef unsigned u32x4 __attribute__((ext_vector_type(4)));
typedef unsigned u32x2 __attribute__((ext_vector_type(2)));
typedef float f32x2_t __attribute__((ext_vector_type(2)));
typedef __bf16 bf16x2_t __attribute__((ext_vector_type(2)));

constexpr int BATCH = 2, SEQ = 16384, DM = 2048, MTOK = BATCH * SEQ, DFF = 5632;
constexpr int SG = 128, SP = 64, SH = 16, SCH = 256, NCH = SEQ / SCH;
constexpr int NHEAD = 16, HD = 128;
constexpr float EPS = 1e-6f;
constexpr int NWAVES = 8;
constexpr size_t MiB = 1u << 20;
constexpr size_t WS_WGLU = 4 * MiB, WS_WQKV = 20 * MiB, WS_WO = 60 * MiB, WS_WGU0 = 68 * MiB, WS_WGU1 = 112 * MiB, WS_WD0 = 156 * MiB, WS_WD1 = 178 * MiB;
constexpr int HP = 136;
constexpr size_t QKV_T = (size_t)BATCH * 16 * SEQ * HP;
constexpr size_t WS_XN = 200 * MiB, WS_BIG = 328 * MiB, WS_Q0 = WS_BIG, WS_Q1 = WS_BIG + 136 * MiB, WS_Q2 = WS_BIG + 272 * MiB, WS_K = WS_BIG + 408 * MiB, WS_V = WS_BIG + 544 * MiB;
constexpr size_t WS_LSE = 1008 * MiB, WS_END = 1012 * MiB;
constexpr size_t WS_U = WS_BIG, WS_SST = WS_BIG + 128 * MiB;
constexpr int LDS_BYTES = 157696;
constexpr int LDS_STG = 135168, STG_WAVE = 2816, STG_PITCH = 80;
constexpr size_t WS_BAR = 2 * MiB;

__device__ __forceinline__ unsigned cvtpk(float lo, float hi) { f32x2_t v = {lo, hi}; bf16x2_t b = __builtin_convertvector(v, bf16x2_t); return __builtin_bit_cast(unsigned, b); }
__device__ __forceinline__ float bf_lo(unsigned w) { return __builtin_bit_cast(float, w << 16); }
__device__ __forceinline__ float bf_hi(unsigned w) { return __builtin_bit_cast(float, w & 0xffff0000u); }
__device__ __forceinline__ float wave_sum(float v) {
#pragma unroll
    for (int o = 1; o < 64; o <<= 1) v += __shfl_xor(v, o);
    return v;
}
__device__ __forceinline__ int crow(int r, int h) { return (r & 3) + 8 * (r >> 2) + 4 * h; }

struct Args { const float* in[20]; float* out; unsigned char* ws; };

__device__ __forceinline__ void p0_item(const float* W, int K, int N, const float* gain, bf16_t* WT, int item, int mode, int Hn, int row_off, LAS float* scr, int lane) {
    const int nblk = N / 32, kb = item / nblk, nb = item % nblk, k0 = 64 * kb, n0 = 32 * nb;
#pragma unroll 8
    for (int i = 0; i < 32; ++i) { const int kk = 2 * i + (lane >> 5); float w = W[(size_t)(k0 + kk) * N + n0 + (lane & 31)]; if (gain) w *= gain[k0 + kk]; scr[kk * 33 + (lane & 31)] = w; }
    asm volatile("s_waitcnt lgkmcnt(0)" ::: "memory");
    int drow0;
    if (mode == 0) drow0 = row_off + n0; else { const int half = n0 >= Hn ? 1 : 0, c = n0 - half * Hn; drow0 = (c >> 7) * 256 + half * 128 + (c & 127); }
    const int c8 = lane & 7;
#pragma unroll
    for (int j = 0; j < 4; ++j) { const int n = (lane >> 3) + 8 * j; const LAS float* s = scr + (8 * c8) * 33 + n;
        u32x4 o; o.x = cvtpk(s[0 * 33], s[1 * 33]); o.y = cvtpk(s[2 * 33], s[3 * 33]); o.z = cvtpk(s[4 * 33], s[5 * 33]); o.w = cvtpk(s[6 * 33], s[7 * 33]);
        *(u32x4*)(WT + (size_t)(drow0 + n) * K + k0 + 8 * c8) = o; }
    asm volatile("s_waitcnt lgkmcnt(0)" ::: "memory");
}
__device__ __forceinline__ void p0_item64(const float* W, int K, int N, const float* gain, bf16_t* WT, int item, int mode, int Hn, int row_off, LAS float* scr, int lane) {
    const int nkb = K / 64, nb = item / nkb, kb = item - nb * nkb, k0 = 64 * kb, n0 = 64 * nb;
    const int lr = lane >> 4, lc = 4 * (lane & 15);
    f32x4 v[16];
#pragma unroll
    for (int i = 0; i < 16; ++i) v[i] = *(const f32x4*)(W + (size_t)(k0 + 4 * i + lr) * N + n0 + lc);
#pragma unroll
    for (int i = 0; i < 16; ++i) { const int k = 4 * i + lr; f32x4 w = v[i]; if (gain) w = w * gain[k0 + k]; *(LAS f32x4*)(scr + k * 64 + (lc ^ (8 * (k >> 3)))) = w; }
    int drow0;
    if (mode == 0) drow0 = row_off + n0; else { const int half = n0 >= Hn ? 1 : 0, c = n0 - half * Hn; drow0 = (c >> 7) * 256 + half * 128 + (c & 127); }
    const int c8 = lane & 7;
#pragma unroll
    for (int j = 0; j < 8; ++j) { const int n = (lane >> 3) + 8 * j; const LAS float* sp = scr + (8 * c8) * 64 + (n ^ (8 * c8));
        u32x4 o; o.x = cvtpk(sp[0 * 64], sp[1 * 64]); o.y = cvtpk(sp[2 * 64], sp[3 * 64]); o.z = cvtpk(sp[4 * 64], sp[5 * 64]); o.w = cvtpk(sp[6 * 64], sp[7 * 64]);
        *(u32x4*)(WT + (size_t)(drow0 + n) * K + k0 + 8 * c8) = o; }
    asm volatile("s_waitcnt lgkmcnt(0)" ::: "memory");
}
__device__ __forceinline__ void norm_row(const float* xrow, const float* gain, bf16_t* orow, int lane) {
    const f32x4* xr = (const f32x4*)xrow + lane;
    f32x4 v[8]; float s = 0.f;
#pragma unroll
    for (int j = 0; j < 8; ++j) { v[j] = xr[64 * j]; s += (v[j].x * v[j].x + v[j].y * v[j].y) + (v[j].z * v[j].z + v[j].w * v[j].w); }
    const float rstd = 1.0f / sqrtf(wave_sum(s) * (1.f / DM) + EPS);
    u32x2* o8 = (u32x2*)orow + lane;
#pragma unroll
    for (int j = 0; j < 8; ++j) { f32x4 g = {1.f, 1.f, 1.f, 1.f}; if (gain) g = ((const f32x4*)gain)[lane + 64 * j];
        u32x2 w; w.x = cvtpk(v[j].x * rstd * g.x, v[j].y * rstd * g.y); w.y = cvtpk(v[j].z * rstd * g.z, v[j].w * rstd * g.w); o8[64 * j] = w; }
}

__device__ __forceinline__ void sincos_acc(float x, float& sn, float& cs) {
    const double xd = (double)x; const double qd = __builtin_rint(xd * 0.63661977236758134308); const float r = (float)(xd - qd * 1.57079632679489661923);
    const int q = ((int)qd) & 3; const float r2 = r * r;
    const float s = r + r * r2 * (-1.6666667e-1f + r2 * (8.3333333e-3f + r2 * (-1.9841270e-4f + r2 * 2.7557319e-6f)));
    const float c = 1.0f + r2 * (-0.5f + r2 * (4.1666667e-2f + r2 * (-1.3888889e-3f + r2 * (2.4801587e-5f + r2 * -2.7557319e-7f))));
    sn = (q == 0) ? s : (q == 1) ? c : (q == 2) ? -s : -c;
    cs = (q == 0) ? c : (q == 1) ? -s : (q == 2) ? -c : s;
}
__device__ __forceinline__ float gelu_tanh(float y) { const float z = 0.7978845608028654f * (y + 0.044715f * y * y * y); return y * __builtin_amdgcn_rcpf(1.0f + __builtin_amdgcn_exp2f(-2.8853900817779268f * z)); }

template <bool OUT> __device__ __forceinline__ void s5_task(const Args& a, int g, int c, LAS unsigned char* wl, int lane) {
    const int n = lane & 31, hh = lane >> 5;
    const float* a_re = a.in[3]; const float* a_im = a.in[4]; const float* log_dt = a.in[5]; const float* b_re = a.in[6]; const float* b_im = a.in[7];
    const float* c_re = a.in[8]; const float* c_im = a.in[9]; const float* dskip = a.in[10];
    const bf16_t* U = (const bf16_t*)(a.ws + WS_U); bf16_t* G = (bf16_t*)(a.ws + WS_XN); float* SST = (float*)(a.ws + WS_SST);
    float lbr[2], lbi[2]; bf16x8 bfr[4];
    const float dt = expf(log_dt[g]);
#pragma unroll
    for (int s = 0; s < 2; ++s) { const int p = n + 32 * s;
        const float lre = fminf(a_re[g * SP + p], -1e-4f), lim = a_im[g * SP + p];
        const float mag = expf(lre * dt); float sn, cs; sincos_acc(lim * dt, sn, cs);
        lbr[s] = mag * cs; lbi[s] = mag * sn;
        const float den = lre * lre + lim * lim, nr = lbr[s] - 1.0f, ni = lbi[s];
        const float cre = (nr * lre + ni * lim) / den, cim = (ni * lre - nr * lim) / den;
        const f32x4* pbr = (const f32x4*)(b_re + (size_t)(g * SP + p) * SH + 8 * hh); const f32x4* pbi = (const f32x4*)(b_im + (size_t)(g * SP + p) * SH + 8 * hh);
        const f32x4 br0 = pbr[0], br1 = pbr[1], bi0 = pbi[0], bi1 = pbi[1];
        float bre[8], bim[8];
#pragma unroll
        for (int i = 0; i < 4; ++i) { bre[i] = cre * br0[i] - cim * bi0[i]; bim[i] = cre * bi0[i] + cim * br0[i]; bre[4 + i] = cre * br1[i] - cim * bi1[i]; bim[4 + i] = cre * bi1[i] + cim * br1[i]; }
        u32x4 w; w.x = cvtpk(bre[0], bre[1]); w.y = cvtpk(bre[2], bre[3]); w.z = cvtpk(bre[4], bre[5]); w.w = cvtpk(bre[6], bre[7]); bfr[s] = __builtin_bit_cast(bf16x8, w);
        w.x = cvtpk(bim[0], bim[1]); w.y = cvtpk(bim[2], bim[3]); w.z = cvtpk(bim[4], bim[5]); w.w = cvtpk(bim[6], bim[7]); bfr[2 + s] = __builtin_bit_cast(bf16x8, w);
    }
    float hre[2] = {0.f, 0.f}, him[2] = {0.f, 0.f};
    bf16x8 cfr[4]; f32x4 dsk = {0.f, 0.f, 0.f, 0.f};
    if (OUT) {
        const int ho = lane & 15, q4 = lane >> 4;
#pragma unroll
        for (int kk = 0; kk < 4; ++kk) { float v[8];
#pragma unroll
            for (int i = 0; i < 8; ++i) { const int nn = 8 * kk + 2 * q4 + (i >> 2), sel = i & 3; const int p = nn + ((sel & 1) ? 32 : 0);
                v[i] = (sel < 2) ? c_re[(size_t)(g * SH + ho) * SP + p] : -c_im[(size_t)(g * SH + ho) * SP + p]; }
            u32x4 w; w.x = cvtpk(v[0], v[1]); w.y = cvtpk(v[2], v[3]); w.z = cvtpk(v[4], v[5]); w.w = cvtpk(v[6], v[7]); cfr[kk] = __builtin_bit_cast(bf16x8, w); }
        dsk = *(const f32x4*)(dskip + g * SH + 4 * q4);
        float pr[2], pi[2];
#pragma unroll
        for (int s = 0; s < 2; ++s) { pr[s] = lbr[s]; pi[s] = lbi[s];
#pragma unroll
            for (int k = 0; k < 8; ++k) { const float nr2 = pr[s] * pr[s] - pi[s] * pi[s], ni2 = 2.0f * pr[s] * pi[s]; pr[s] = nr2; pi[s] = ni2; } }
        const float* sp = SST + ((size_t)(hh * SG + g) * SP + n) * 2;
#pragma unroll 4
        for (int cc = 0; cc < c; ++cc) { const f32x2_t s0 = *(const f32x2_t*)(sp + (size_t)cc * (2 * SG * SP * 2)); const f32x2_t s1 = *(const f32x2_t*)(sp + (size_t)cc * (2 * SG * SP * 2) + 64);
            float t0 = pr[0] * hre[0] - pi[0] * him[0] + s0.x, t1 = pr[0] * him[0] + pi[0] * hre[0] + s0.y; hre[0] = t0; him[0] = t1;
            t0 = pr[1] * hre[1] - pi[1] * him[1] + s1.x; t1 = pr[1] * him[1] + pi[1] * hre[1] + s1.y; hre[1] = t0; him[1] = t1; }
    }
    const bf16_t* up = U + ((size_t)(((n >> 2) & 1) * SEQ + c * SCH + (n & 3) + 4 * (n >> 3)) * DM + g * SH + 8 * hh);
    bf16x8 afr = *(const bf16x8*)up;
    const f32x16 z16 = {0.f, 0.f, 0.f, 0.f, 0.f, 0.f, 0.f, 0.f, 0.f, 0.f, 0.f, 0.f, 0.f, 0.f, 0.f, 0.f};
    for (int st = 0; st < SCH / 16; ++st) {
        const bf16x8 acur = afr;
        if (st + 1 < SCH / 16) afr = *(const bf16x8*)(up + (size_t)(st + 1) * 16 * DM);
        f32x16 D0 = __builtin_amdgcn_mfma_f32_32x32x16_bf16(acur, bfr[0], z16, 0, 0, 0);
        f32x16 D1 = __builtin_amdgcn_mfma_f32_32x32x16_bf16(acur, bfr[1], z16, 0, 0, 0);
        f32x16 D2 = __builtin_amdgcn_mfma_f32_32x32x16_bf16(acur, bfr[2], z16, 0, 0, 0);
        f32x16 D3 = __builtin_amdgcn_mfma_f32_32x32x16_bf16(acur, bfr[3], z16, 0, 0, 0);
#pragma unroll
        for (int r = 0; r < 16; ++r) {
            float t0 = fmaf(lbr[0], hre[0], fmaf(-lbi[0], him[0], D0[r])), t1 = fmaf(lbr[0], him[0], fmaf(lbi[0], hre[0], D2[r])); hre[0] = t0; him[0] = t1;
            t0 = fmaf(lbr[1], hre[1], fmaf(-lbi[1], him[1], D1[r])); t1 = fmaf(lbr[1], him[1], fmaf(lbi[1], hre[1], D3[r])); hre[1] = t0; him[1] = t1;
            if (OUT) { u32x2 w; w.x = cvtpk(hre[0], hre[1]); w.y = cvtpk(him[0], him[1]); *(LAS u32x2*)(wl + (hh * 16 + r) * 320 + 8 * n) = w; }
        }
        if (OUT) {
            const int tk = lane & 15, q4 = lane >> 4;
#pragma unroll
            for (int tt = 0; tt < 2; ++tt) {
                f32x4 y = {0.f, 0.f, 0.f, 0.f};
#pragma unroll
                for (int kk = 0; kk < 4; ++kk) { const bf16x8 hb = *(const LAS bf16x8*)(wl + (tt * 16 + tk) * 320 + (32 * kk + 8 * q4) * 2); y = __builtin_amdgcn_mfma_f32_16x16x32_bf16(cfr[kk], hb, y, 0, 0, 0); }
                const size_t idx = (size_t)(tt * SEQ + c * SCH + st * 16 + tk) * DM + g * SH + 4 * q4;
                const u32x2 uu = *(const u32x2*)(U + idx);
                const float y0 = y[0] + dsk[0] * bf_lo(uu.x), y1 = y[1] + dsk[1] * bf_hi(uu.x), y2 = y[2] + dsk[2] * bf_lo(uu.y), y3 = y[3] + dsk[3] * bf_hi(uu.y);
                u32x2 w; w.x = cvtpk(gelu_tanh(y0), gelu_tanh(y1)); w.y = cvtpk(gelu_tanh(y2), gelu_tanh(y3)); *(u32x2*)(G + idx) = w;
            }
        }
    }
    if (!OUT) {
        float* sp = SST + ((size_t)((c * 2 + hh) * SG + g) * SP + n) * 2;
        *(f32x2_t*)sp = (f32x2_t){hre[0], him[0]}; *(f32x2_t*)(sp + 64) = (f32x2_t){hre[1], him[1]};
    }
}

__device__ __forceinline__ unsigned off_b(unsigned row, unsigned ch) { return 256u * row + 16u * (ch ^ (((row & 3) << 2) | ((row >> 2) & 3))); }
typedef short v4i16_t __attribute__((ext_vector_type(4)));
__device__ __forceinline__ s16x4 vtr(const LAS unsigned char* p) { return __builtin_bit_cast(s16x4, __builtin_amdgcn_ds_read_tr16_b64_v4i16((LAS v4i16_t*)p)); }

__device__ __forceinline__ void att_glds16(const void* gsrc, unsigned lds_dst) { unsigned keep;
    asm volatile("s_mov_b32 %0, m0\n\ts_mov_b32 m0, %2\n\ts_nop 0\n\tglobal_load_lds_dwordx4 %1, off\n\ts_mov_b32 m0, %0" : "=&s"(keep) : "v"(gsrc), "s"(lds_dst) : "memory"); }
template <int GRP> __device__ __forceinline__ void attn_q_load(const Args& a, int b, int head, int Ts, int uidx, int lane, u32x4 (&raw)[8]) {
    constexpr int dil = (GRP == 0) ? 1 : (GRP == 1) ? 4 : 16;
    const bf16_t* Qg = (const bf16_t*)(a.ws + (GRP == 0 ? WS_Q0 : GRP == 1 ? WS_Q1 : WS_Q2));
    constexpr int nblk = 64 / dil;
    const int n = lane & 31, h = lane >> 5, r = uidx / nblk, blk = uidx % nblk, tq = Ts + r + dil * (32 * blk + n);
    const bf16_t* qrow = Qg + ((size_t)((b * 16 + head) * SEQ + tq) * HP);
#pragma unroll
    for (int kk = 0; kk < 8; ++kk) raw[kk] = *(const u32x4*)(qrow + 16 * kk + 8 * h);
}
template <int GRP> __device__ __forceinline__ void attn_unit(const Args& a, int b, int head, int Ts, int uidx, int unext, LAS unsigned char* vl, int lane, u32x4 (&raw)[8]) {
    constexpr int dil = (GRP == 0) ? 1 : (GRP == 1) ? 4 : 16;
    constexpr float THR = 40.0f;
    const int n = lane & 31, h = lane >> 5;
    bf16_t* Qg = (bf16_t*)(a.ws + (GRP == 0 ? WS_Q0 : GRP == 1 ? WS_Q1 : WS_Q2));
    const bf16_t* Kb = (const bf16_t*)(a.ws + WS_K); const bf16_t* Vb = (const bf16_t*)(a.ws + WS_V);
    float* LSE = (float*)(a.ws + WS_LSE);
    const float* qn = a.in[16] + GRP * HD;
    constexpr int nblk = 64 / dil;
    const int r = uidx / nblk, blk = uidx % nblk;
    const int tq = Ts + r + dil * (32 * blk + n);
    bf16_t* qrow = Qg + ((size_t)((b * 16 + head) * SEQ + tq) * HP);
    int kt = (5 - blk % 5) % 5;
    const int vrow_l = lane >> 4; const int vch[4] = {(lane & 15) ^ ((vrow_l << 2) | 0), (lane & 15) ^ ((vrow_l << 2) | 1), (lane & 15) ^ ((vrow_l << 2) | 2), (lane & 15) ^ ((vrow_l << 2) | 3)};
    const bf16_t* vbase = Vb + ((size_t)(b * 16 + head) * SEQ * HP);
    const unsigned vlds0 = (unsigned)(uintptr_t)vl;
    const bf16_t* kbase = Kb + ((size_t)(b * 16 + head) * SEQ * HP);
#define ATT_DMA_T(base_, kt_, buf_) do { const int jb_ = 32 * blk - 128 + 32 * (kt_); _Pragma("unroll") for (int i_ = 0; i_ < 8; ++i_) { int tk_ = Ts + r + dil * (jb_ + 4 * i_ + vrow_l); tk_ = tk_ < 0 ? 0 : tk_; \
        att_glds16((base_) + (size_t)tk_ * HP + 8 * vch[i_ & 3], (unsigned)__builtin_amdgcn_readfirstlane((int)(vlds0 + (buf_) * 8192 + i_ * 1024))); } } while (0)
    asm volatile("" ::: "memory");
    ATT_DMA_T(kbase, kt, 0);
    ATT_DMA_T(vbase, kt, 1);
    asm volatile("" ::: "memory");
    const unsigned kx = ((n & 3) << 2) | ((n >> 2) & 3);
    bf16x8 qf[8];
    {
        float ss = 0.f;
#pragma unroll
        for (int kk = 0; kk < 8; ++kk)
#pragma unroll
            for (int e = 0; e < 4; ++e) { const float lo = bf_lo(raw[kk][e]), hi = bf_hi(raw[kk][e]); ss += lo * lo + hi * hi; }
        ss += __shfl_xor(ss, 32);
        const float sc = (1.0f / sqrtf(ss * (1.f / HD) + EPS)) * 0.08838834764831845f * 1.4426950408889634f;
#pragma unroll
        for (int kk = 0; kk < 8; ++kk) { const f32x4 g0 = *(const f32x4*)(qn + 16 * kk + 8 * h), g1 = *(const f32x4*)(qn + 16 * kk + 8 * h + 4); u32x4 w;
            w.x = cvtpk(bf_lo(raw[kk].x) * sc * g0.x, bf_hi(raw[kk].x) * sc * g0.y); w.y = cvtpk(bf_lo(raw[kk].y) * sc * g0.z, bf_hi(raw[kk].y) * sc * g0.w);
            w.z = cvtpk(bf_lo(raw[kk].z) * sc * g1.x, bf_hi(raw[kk].z) * sc * g1.y); w.w = cvtpk(bf_lo(raw[kk].w) * sc * g1.z, bf_hi(raw[kk].w) * sc * g1.w);
            qf[kk] = __builtin_bit_cast(bf16x8, w); }
    }
    const float slope2 = exp2f(-8.0f * (float)(3 * head + GRP + 1) / 48.0f) * (float)dil * 1.4426950408889634f;
    float m = 0.f, l = 0.f;
    const f32x16 z16 = {0.f, 0.f, 0.f, 0.f, 0.f, 0.f, 0.f, 0.f, 0.f, 0.f, 0.f, 0.f, 0.f, 0.f, 0.f, 0.f};
    f32x16 O[4] = {z16, z16, z16, z16};
    unsigned tro[2][2], cbo[4];
    { const unsigned blk2 = (lane >> 4) & 1, q = (lane & 15) >> 2, p = lane & 3;
#pragma unroll
      for (int s = 0; s < 2; ++s)
#pragma unroll
        for (int t = 0; t < 2; ++t) { const unsigned row = 16 * s + 4 * h + 8 * t + q; tro[s][t] = 256u * row + 16u * ((2 * blk2 + (p >> 1)) ^ ((row >> 2) & 3)) + 8 * (p & 1); }
#pragma unroll
      for (int cb = 0; cb < 4; ++cb) cbo[cb] = 64u * ((unsigned)cb ^ q); }
#pragma unroll 1
    for (int st = 0; st < 5; ++st) {
        const bool has_next = st < 4; const int ktn = (kt == 4) ? 0 : kt + 1;
        const int jbase = 32 * blk - 128 + 32 * kt;
        const float lb = -slope2 * (float)(128 - 32 * kt + n - 4 * h) - m;
        f32x16 S;
#pragma unroll
        for (int rr = 0; rr < 16; ++rr) S[rr] = fmaf(slope2, (float)((rr & 3) + 8 * (rr >> 2)), lb);
        asm volatile("s_waitcnt vmcnt(8)" ::: "memory");
        bf16x8 kf[8];
#pragma unroll
        for (int kk = 0; kk < 8; ++kk) kf[kk] = *(const LAS bf16x8*)(vl + 256 * n + 16 * ((unsigned)(2 * kk + h) ^ kx));
#pragma unroll
        for (int kk = 0; kk < 8; ++kk) S = __builtin_amdgcn_mfma_f32_32x32x16_bf16(kf[kk], qf[kk], S, 0, 0, 0);
        asm volatile("s_waitcnt lgkmcnt(0)" ::: "memory");
        if (has_next) ATT_DMA_T(kbase, ktn, 0);
        asm volatile("" ::: "memory");
        if (kt == 0 || kt == 4 || Ts + r + dil * jbase < 0) {
#pragma unroll
            for (int rr = 0; rr < 16; ++rr) { const int j = crow(rr, h); const int dist = 128 - 32 * kt + n - j; const bool ok = (dist >= 0) && (dist <= 128) && (Ts + r + dil * (jbase + j) >= 0);
                S[rr] = ok ? S[rr] : -INFINITY; }
        }
        float tmax = fmaxf(fmaxf(S[0], S[1]), fmaxf(S[2], S[3]));
#pragma unroll
        for (int rr = 4; rr < 16; rr += 4) tmax = fmaxf(tmax, fmaxf(fmaxf(S[rr], S[rr + 1]), fmaxf(S[rr + 2], S[rr + 3])));
        tmax = fmaxf(tmax, __shfl_xor(tmax, 32));
        if (__builtin_expect(__any(tmax > THR), 0)) {
            const float dl = tmax > THR ? tmax : 0.f; const float f = __builtin_amdgcn_exp2f(-dl); m += dl; l *= f;
#pragma unroll
            for (int rr = 0; rr < 16; ++rr) S[rr] -= dl;
#pragma unroll
            for (int cb = 0; cb < 4; ++cb)
#pragma unroll
                for (int rr = 0; rr < 16; ++rr) O[cb][rr] *= f;
        }
        float ps = 0.f;
#pragma unroll
        for (int rr = 0; rr < 16; ++rr) { const float p = __builtin_amdgcn_exp2f(S[rr]); S[rr] = p; ps += p; }
        l += ps;
        bf16x8 pf[2];
#pragma unroll
        for (int s = 0; s < 2; ++s) { u32x4 w; w.x = cvtpk(S[8 * s + 0], S[8 * s + 1]); w.y = cvtpk(S[8 * s + 2], S[8 * s + 3]); w.z = cvtpk(S[8 * s + 4], S[8 * s + 5]); w.w = cvtpk(S[8 * s + 6], S[8 * s + 7]); pf[s] = __builtin_bit_cast(bf16x8, w); }
        if (has_next) asm volatile("s_waitcnt vmcnt(8)" ::: "memory"); else asm volatile("s_waitcnt vmcnt(0)" ::: "memory");
        const LAS unsigned char* vb = vl + 8192;
#pragma unroll
        for (int cb = 0; cb < 4; ++cb)
#pragma unroll
            for (int s = 0; s < 2; ++s) { const s16x4 lo = vtr(vb + tro[s][0] + cbo[cb]), hi = vtr(vb + tro[s][1] + cbo[cb]);
                const bf16x8 vf = {lo[0], lo[1], lo[2], lo[3], hi[0], hi[1], hi[2], hi[3]};
                O[cb] = __builtin_amdgcn_mfma_f32_32x32x16_bf16(vf, pf[s], O[cb], 0, 0, 0); }
        asm volatile("s_waitcnt lgkmcnt(0)" ::: "memory");
        if (has_next) ATT_DMA_T(vbase, ktn, 1);
        asm volatile("" ::: "memory");
        __builtin_amdgcn_s_barrier();
        kt = ktn;
    }
#undef ATT_DMA_T
    const float lt = l + __shfl_xor(l, 32);
    const float lse2 = m + __builtin_amdgcn_logf(lt);
    float w0 = 1.0f / lt, w1 = 0.f, w2 = 0.f;
    const size_t hrow = (size_t)(b * 16 + head) * SEQ + tq;
    if (GRP != 0) { if (h == 0) LSE[(size_t)(GRP - 1) * MTOK * NHEAD + hrow] = lse2; }
    else { const float l1 = LSE[hrow], l2 = LSE[(size_t)MTOK * NHEAD + hrow];
        const float mx = fmaxf(lse2, fmaxf(l1, l2)); const float e0 = __builtin_amdgcn_exp2f(lse2 - mx), e1 = __builtin_amdgcn_exp2f(l1 - mx), e2 = __builtin_amdgcn_exp2f(l2 - mx);
        const float inv = 1.0f / (e0 + e1 + e2); w0 = e0 * inv / lt; w1 = e1 * inv; w2 = e2 * inv; }
    const bf16_t* o1row = (const bf16_t*)(a.ws + WS_Q1) + hrow * HP; const bf16_t* o2row = (const bf16_t*)(a.ws + WS_Q2) + hrow * HP;
    bf16_t* orow = (GRP == 0) ? (bf16_t*)a.out + ((size_t)(b * SEQ + tq) * DM + head * HD) : qrow;
#pragma unroll
    for (int cb = 0; cb < 4; ++cb)
#pragma unroll
        for (int rg = 0; rg < 4; ++rg) { const int d0 = 32 * cb + 8 * rg + 4 * h;
            float o0 = O[cb][4 * rg + 0] * w0, o1 = O[cb][4 * rg + 1] * w0, o2 = O[cb][4 * rg + 2] * w0, o3 = O[cb][4 * rg + 3] * w0;
            if (GRP == 0) { const u32x2 x1 = *(const u32x2*)(o1row + d0), x2 = *(const u32x2*)(o2row + d0);
                o0 += w1 * bf_lo(x1.x) + w2 * bf_lo(x2.x); o1 += w1 * bf_hi(x1.x) + w2 * bf_hi(x2.x); o2 += w1 * bf_lo(x1.y) + w2 * bf_lo(x2.y); o3 += w1 * bf_hi(x1.y) + w2 * bf_hi(x2.y); }
            u32x2 w; w.x = cvtpk(o0, o1); w.y = cvtpk(o2, o3); *(u32x2*)(orow + d0) = w; }
}
template <int GRP> __device__ __forceinline__ void attn_stage(const Args& a, int b, int head, int Ts, int wave, LAS unsigned char* vl, int lane) {
    asm volatile("" : "+v"(lane));
    u32x4 raw[8];
    for (int u = wave; u < 64; u += NWAVES) { attn_q_load<GRP>(a, b, head, Ts, u, lane, raw); attn_unit<GRP>(a, b, head, Ts, u, (u + NWAVES < 64) ? u + NWAVES : -1, vl, lane, raw); }
}


struct AttStep { int dil, grp, rd, s, B0, nbr; };
__device__ __forceinline__ AttStep att_decode(int S) { AttStep t; const int st = S / 40; t.rd = (S % 40) / 5; t.s = S % 5; t.dil = st == 0 ? 16 : st == 1 ? 4 : 1; t.grp = 2 - st;
    t.B0 = (t.dil == 16) ? 0 : (t.dil == 4 ? (t.rd & 1) * 8 : t.rd * 8); t.nbr = (t.dil == 16) ? 4 : 8; return t; }
__device__ __forceinline__ int att_res(const AttStep& t, int group) { return (t.dil == 16) ? 2 * t.rd + group : (t.dil == 4 ? (t.rd >> 1) : 0); }
__device__ __forceinline__ int att_tmin(const AttStep& t) { return t.B0 + ((t.s - t.B0 % 5 + 5) % 5); }
__device__ __forceinline__ void attn_shared(const Args& a, int b, int head, int Ts, int wave, LAS unsigned char* lds, int lane) {
    asm volatile("" : "+v"(lane));
    LAS float* gl = (LAS float*)(lds + 131072 + 1024);
    { const int tix = wave * 64 + lane; if (tix < 3 * HD) gl[tix] = a.in[16][tix]; }
    asm volatile("" ::: "memory");
    constexpr float THR = 40.0f;
    const int n = lane & 31, h = lane >> 5;
    const bf16_t* kbase = (const bf16_t*)(a.ws + WS_K) + ((size_t)(b * 16 + head) * SEQ * HP);
    const bf16_t* vbase = (const bf16_t*)(a.ws + WS_V) + ((size_t)(b * 16 + head) * SEQ * HP);
    float* LSE = (float*)(a.ws + WS_LSE);
    const unsigned lds0 = (unsigned)(uintptr_t)lds;
    const int vrow_l = lane >> 4;
    const unsigned kx = ((n & 3) << 2) | ((n >> 2) & 3);
    unsigned tro[2][2], q64;
    { const unsigned blk2 = (lane >> 4) & 1, q = (lane & 15) >> 2, p = lane & 3;
#pragma unroll
      for (int s = 0; s < 2; ++s)
#pragma unroll
        for (int t = 0; t < 2; ++t) { const unsigned row = 16 * s + 4 * h + 8 * t + q; tro[s][t] = 256u * row + 16u * ((2 * blk2 + (p >> 1)) ^ ((row >> 2) & 3)) + 8 * (p & 1); }
      q64 = 64u * q; }
#define ATT_ISSUE(Sx_) do { const AttStep t_ = att_decode(Sx_); const int tmin_ = att_tmin(t_); \
        _Pragma("unroll") for (int slot_ = 0; slot_ < 4; ++slot_) { const int gi_ = (t_.dil == 16) ? (slot_ >> 1) : 0, idx_ = (t_.dil == 16) ? (slot_ & 1) : slot_; const int T_ = tmin_ + 5 * idx_; \
            if (T_ <= t_.B0 + t_.nbr + 3 && (t_.dil == 16 || slot_ < 3)) { int tk_ = Ts + att_res(t_, gi_) + t_.dil * (32 * (T_ - 4) + 4 * wave + vrow_l); tk_ = tk_ < 0 ? 0 : tk_; \
                const size_t go_ = (size_t)tk_ * HP + 8 * ((lane & 15) ^ ((vrow_l << 2) | (wave & 3))); const unsigned ld_ = lds0 + (((Sx_) & 1) * 65536 + slot_ * 16384 + wave * 1024); \
                att_glds16(kbase + go_, (unsigned)__builtin_amdgcn_readfirstlane((int)ld_)); att_glds16(vbase + go_, (unsigned)__builtin_amdgcn_readfirstlane((int)(ld_ + 8192))); } } } while (0)
#define ATT_QROW(t_, grp_) ((bf16_t*)(a.ws + ((grp_) == 0 ? WS_Q0 : (grp_) == 1 ? WS_Q1 : WS_Q2)) + ((size_t)((b * 16 + head) * SEQ + Ts + att_res(t_, (t_.dil == 16) ? (wave >> 2) : 0) + t_.dil * (32 * (t_.B0 + ((t_.dil == 16) ? (wave & 3) : wave)) + n)) * HP))
    u32x4 raw[8];
    { const AttStep t0 = att_decode(0); const bf16_t* qr = ATT_QROW(t0, t0.grp);
#pragma unroll
      for (int kk = 0; kk < 8; ++kk) raw[kk] = *(const u32x4*)(qr + 16 * kk + 8 * h); }
    asm volatile("" ::: "memory");
    ATT_ISSUE(0);
    asm volatile("s_waitcnt vmcnt(0) lgkmcnt(0)" ::: "memory"); __builtin_amdgcn_s_barrier(); asm volatile("" ::: "memory");
    bf16x8 qf[8]; float slope2 = 0.f, m = 0.f, l = 0.f;
    const f32x16 z16 = {0.f, 0.f, 0.f, 0.f, 0.f, 0.f, 0.f, 0.f, 0.f, 0.f, 0.f, 0.f, 0.f, 0.f, 0.f, 0.f};
    f32x16 O[4] = {z16, z16, z16, z16};
#pragma unroll 1
    for (int S = 0; S < 120; ++S) {
        const AttStep t = att_decode(S);
        asm volatile("" ::: "memory");
        if (S + 1 < 120) ATT_ISSUE(S + 1);
        asm volatile("" ::: "memory");
        const int group = (t.dil == 16) ? (wave >> 2) : 0, B = t.B0 + ((t.dil == 16) ? (wave & 3) : wave), r = att_res(t, group);
        if (t.s == 4 && S + 1 < 120) {
            const AttStep tn = att_decode(S + 1); const bf16_t* qr = ATT_QROW(tn, tn.grp);
#pragma unroll
            for (int kk = 0; kk < 8; ++kk) raw[kk] = *(const u32x4*)(qr + 16 * kk + 8 * h); }
        if (t.s == 0) {
            const LAS float* qn = gl + t.grp * HD; float ss = 0.f;
#pragma unroll
            for (int kk = 0; kk < 8; ++kk)
#pragma unroll
                for (int e = 0; e < 4; ++e) { const float lo = bf_lo(raw[kk][e]), hi = bf_hi(raw[kk][e]); ss += lo * lo + hi * hi; }
            ss += __shfl_xor(ss, 32);
            const float sc = (1.0f / sqrtf(ss * (1.f / HD) + EPS)) * 0.08838834764831845f * 1.4426950408889634f;
#pragma unroll
            for (int kk = 0; kk < 8; ++kk) { const f32x4 g0 = *(const LAS f32x4*)(qn + 16 * kk + 8 * h), g1 = *(const LAS f32x4*)(qn + 16 * kk + 8 * h + 4); u32x4 w;
                w.x = cvtpk(bf_lo(raw[kk].x) * sc * g0.x, bf_hi(raw[kk].x) * sc * g0.y); w.y = cvtpk(bf_lo(raw[kk].y) * sc * g0.z, bf_hi(raw[kk].y) * sc * g0.w);
                w.z = cvtpk(bf_lo(raw[kk].z) * sc * g1.x, bf_hi(raw[kk].z) * sc * g1.y); w.w = cvtpk(bf_lo(raw[kk].w) * sc * g1.z, bf_hi(raw[kk].w) * sc * g1.w);
                qf[kk] = __builtin_bit_cast(bf16x8, w); }
            slope2 = exp2f(-8.0f * (float)(3 * head + t.grp + 1) / 48.0f) * (float)t.dil * 1.4426950408889634f;
            m = 0.f; l = 0.f;
#pragma unroll
            for (int cb = 0; cb < 4; ++cb) O[cb] = z16;
        }
        const int kt = (t.s - B % 5 + 5) % 5, T = B + kt, slot = ((t.dil == 16) ? 2 * group : 0) + (T - att_tmin(t)) / 5;
        const LAS unsigned char* kl = lds + ((S & 1) * 65536 + slot * 16384);
        const int jbase = 32 * (T - 4);
        const float lb = -slope2 * (float)(128 - 32 * kt + n - 4 * h) - m;
        f32x16 Sc;
#pragma unroll
        for (int rr = 0; rr < 16; ++rr) Sc[rr] = fmaf(slope2, (float)((rr & 3) + 8 * (rr >> 2)), lb);
        { bf16x8 kf[8];
#pragma unroll
          for (int kk = 0; kk < 8; ++kk) kf[kk] = *(const LAS bf16x8*)(kl + 256 * n + 16 * ((unsigned)(2 * kk + h) ^ kx));
#pragma unroll
          for (int kk = 0; kk < 8; ++kk) Sc = __builtin_amdgcn_mfma_f32_32x32x16_bf16(kf[kk], qf[kk], Sc, 0, 0, 0); }
        if (Ts + r + t.dil * jbase < 0) {
#pragma unroll
            for (int rr = 0; rr < 16; ++rr) { const int j = crow(rr, h); const int dist = 128 - 32 * kt + n - j; const bool ok = (dist >= 0) && (dist <= 128) && (Ts + r + t.dil * (jbase + j) >= 0);
                Sc[rr] = ok ? Sc[rr] : -INFINITY; }
        } else if (kt == 0) {
#pragma unroll
            for (int rr = 0; rr < 16; ++rr) Sc[rr] = (crow(rr, h) >= n) ? Sc[rr] : -INFINITY;
        } else if (kt == 4) {
#pragma unroll
            for (int rr = 0; rr < 16; ++rr) Sc[rr] = (crow(rr, h) <= n) ? Sc[rr] : -INFINITY;
        }
        float tmax = fmaxf(fmaxf(Sc[0], Sc[1]), fmaxf(Sc[2], Sc[3]));
#pragma unroll
        for (int rr = 4; rr < 16; rr += 4) tmax = fmaxf(tmax, fmaxf(fmaxf(Sc[rr], Sc[rr + 1]), fmaxf(Sc[rr + 2], Sc[rr + 3])));
        if (__builtin_expect(__any(tmax > THR), 0)) {
            tmax = fmaxf(tmax, __shfl_xor(tmax, 32));
            const float dl = tmax > THR ? tmax : 0.f; const float f = __builtin_amdgcn_exp2f(-dl); m += dl; l *= f;
#pragma unroll
            for (int rr = 0; rr < 16; ++rr) Sc[rr] -= dl;
#pragma unroll
            for (int cb = 0; cb < 4; ++cb)
#pragma unroll
                for (int rr = 0; rr < 16; ++rr) O[cb][rr] *= f;
        }
        float ps = 0.f;
#pragma unroll
        for (int rr = 0; rr < 16; ++rr) { const float p = __builtin_amdgcn_exp2f(Sc[rr]); Sc[rr] = p; ps += p; }
        l += ps;
        bf16x8 pf[2];
#pragma unroll
        for (int s2 = 0; s2 < 2; ++s2) { u32x4 w; w.x = cvtpk(Sc[8 * s2 + 0], Sc[8 * s2 + 1]); w.y = cvtpk(Sc[8 * s2 + 2], Sc[8 * s2 + 3]); w.z = cvtpk(Sc[8 * s2 + 4], Sc[8 * s2 + 5]); w.w = cvtpk(Sc[8 * s2 + 6], Sc[8 * s2 + 7]); pf[s2] = __builtin_bit_cast(bf16x8, w); }
        { const LAS unsigned char* vb = kl + 8192;
#pragma unroll
          for (int cb = 0; cb < 4; ++cb)
#pragma unroll
            for (int s2 = 0; s2 < 2; ++s2) { const unsigned co = (64u * cb) ^ q64; const s16x4 lo = vtr(vb + tro[s2][0] + co), hi = vtr(vb + tro[s2][1] + co);
                const bf16x8 vf = {lo[0], lo[1], lo[2], lo[3], hi[0], hi[1], hi[2], hi[3]};
                O[cb] = __builtin_amdgcn_mfma_f32_32x32x16_bf16(vf, pf[s2], O[cb], 0, 0, 0); } }
        if (t.s == 4) {
            const int tq = Ts + r + t.dil * (32 * B + n);
            const float lt = l + __shfl_xor(l, 32);
            const float lse2 = m + __builtin_amdgcn_logf(lt);
            float w0 = 1.0f / lt, w1 = 0.f, w2 = 0.f;
            const size_t hrow = (size_t)(b * 16 + head) * SEQ + tq;
            if (t.grp != 0) { if (h == 0) LSE[(size_t)(t.grp - 1) * MTOK * NHEAD + hrow] = lse2; }
            else { const float l1 = LSE[hrow], l2 = LSE[(size_t)MTOK * NHEAD + hrow];
                const float mx = fmaxf(lse2, fmaxf(l1, l2)); const float e0 = __builtin_amdgcn_exp2f(lse2 - mx), e1 = __builtin_amdgcn_exp2f(l1 - mx), e2 = __builtin_amdgcn_exp2f(l2 - mx);
                const float inv = 1.0f / (e0 + e1 + e2); w0 = e0 * inv / lt; w1 = e1 * inv; w2 = e2 * inv; }
            LAS unsigned char* stg = lds + LDS_STG + wave * STG_WAVE; LAS float* wq = (LAS float*)(stg + 32 * STG_PITCH);
            if (t.grp == 0 && h == 0) { wq[2 * n] = w1; wq[2 * n + 1] = w2; }
            const bf16_t* o1b = (const bf16_t*)(a.ws + WS_Q1); const bf16_t* o2b = (const bf16_t*)(a.ws + WS_Q2);
            bf16_t* ogb = (bf16_t*)(a.ws + (t.grp == 1 ? WS_Q1 : WS_Q2));
#pragma unroll
            for (int cb = 0; cb < 4; ++cb) {
#pragma unroll
                for (int rg = 0; rg < 4; ++rg) { u32x2 w; w.x = cvtpk(O[cb][4 * rg + 0] * w0, O[cb][4 * rg + 1] * w0); w.y = cvtpk(O[cb][4 * rg + 2] * w0, O[cb][4 * rg + 3] * w0);
                    *(LAS u32x2*)(stg + n * STG_PITCH + 16 * rg + 8 * h) = w; }
#pragma unroll
                for (int j = 0; j < 2; ++j) { const int c = lane + 64 * j, row = c >> 2, part = c & 3;
                    const u32x4 v = *(const LAS u32x4*)(stg + row * STG_PITCH + part * 16);
                    const int tqr = Ts + r + t.dil * (32 * B + row); const size_t hr = (size_t)(b * 16 + head) * SEQ + tqr; const int dcol = 32 * cb + 8 * part;
                    if (t.grp == 0) { const u32x4 x1 = *(const u32x4*)(o1b + hr * HP + dcol), x2 = *(const u32x4*)(o2b + hr * HP + dcol); const float a1 = wq[2 * row], a2 = wq[2 * row + 1]; u32x4 o;
                        o.x = cvtpk(bf_lo(v.x) + a1 * bf_lo(x1.x) + a2 * bf_lo(x2.x), bf_hi(v.x) + a1 * bf_hi(x1.x) + a2 * bf_hi(x2.x));
                        o.y = cvtpk(bf_lo(v.y) + a1 * bf_lo(x1.y) + a2 * bf_lo(x2.y), bf_hi(v.y) + a1 * bf_hi(x1.y) + a2 * bf_hi(x2.y));
                        o.z = cvtpk(bf_lo(v.z) + a1 * bf_lo(x1.z) + a2 * bf_lo(x2.z), bf_hi(v.z) + a1 * bf_hi(x1.z) + a2 * bf_hi(x2.z));
                        o.w = cvtpk(bf_lo(v.w) + a1 * bf_lo(x1.w) + a2 * bf_lo(x2.w), bf_hi(v.w) + a1 * bf_hi(x1.w) + a2 * bf_hi(x2.w));
                        *(u32x4*)((bf16_t*)a.out + ((size_t)(b * SEQ + tqr) * DM + head * HD + dcol)) = o; }
                    else *(u32x4*)(ogb + hr * HP + dcol) = v;
                    asm volatile("" ::: "memory"); }
                asm volatile("" ::: "memory");
            }
        }
        if (S == 79) __threadfence();
        if (t.s == 4 && S != 79) asm volatile("s_waitcnt vmcnt(8) lgkmcnt(0)" ::: "memory");
        else asm volatile("s_waitcnt vmcnt(0) lgkmcnt(0)" ::: "memory");
        __builtin_amdgcn_s_barrier(); asm volatile("" ::: "memory");
        if (S == 79) __builtin_amdgcn_fence(__ATOMIC_ACQUIRE, "agent");
    }
#undef ATT_ISSUE
#undef ATT_QROW
}

#define XB_TMO      128
#define XB_XCNT(j)  (256  + 64 * (j))
#define XB_XSUB(j)  (1280 + 64 * (j))
#define XB_XGEN(j)  (2304 + 64 * (j))
#define XB_TOP      3328
#define XB_TOPGEN   3392
#define XCD_BAR_WORDS 3456
#define XB_SPIN_CAP (1u << 18)

__device__ __forceinline__ unsigned xb_ld(unsigned* p)              { return __hip_atomic_load(p, __ATOMIC_RELAXED, __HIP_MEMORY_SCOPE_AGENT); }
__device__ __forceinline__ unsigned xb_add(unsigned* p, unsigned v) { return __hip_atomic_fetch_add(p, v, __ATOMIC_RELAXED, __HIP_MEMORY_SCOPE_AGENT); }
__device__ __forceinline__ unsigned xb_xcc_id() { return (unsigned)__builtin_amdgcn_s_getreg((3 << 11) | 20) & 0xFu; }
#define XB_SPIN(cond, bar) do { unsigned _sp = 0; while (cond) { __builtin_amdgcn_s_sleep(1); \
    if ((++_sp & 255u) == 0u) { if (xb_ld(&(bar)[XB_TMO])) break; if (_sp > XB_SPIN_CAP) { atomicAdd(&(bar)[XB_TMO], 1u); break; } } } } while (0)

struct XcdBarrier {
    unsigned* bar; unsigned x;
    volatile LAS unsigned* st;
};

__device__ __forceinline__ XcdBarrier xcd_barrier_post(unsigned* bar, volatile LAS unsigned* st) {
    XcdBarrier b; b.bar = bar; b.x = xb_xcc_id(); b.st = st;
    if (threadIdx.x == 0) (void)xb_add(&bar[XB_XCNT(b.x)], 1u);
    return b;
}
__device__ __forceinline__ void xcd_barrier_complete(unsigned* bar, unsigned x, unsigned& nloc, unsigned& nx) {
    const unsigned G = gridDim.x * gridDim.y * gridDim.z;
    unsigned sum, cnt, mine, sp = 0u;
    for (;;) {
        sum = 0u; cnt = 0u; mine = 0u;
#pragma unroll
        for (unsigned j = 0; j < 16; ++j) { const unsigned c = xb_ld(&bar[XB_XCNT(j)]); sum += c; cnt += (c > 0u) ? 1u : 0u; mine = (j == x) ? c : mine; }
        if (sum == G) break;
        __builtin_amdgcn_s_sleep(1);
        if ((++sp & 255u) == 0u) { if (xb_ld(&bar[XB_TMO])) break; if (sp > XB_SPIN_CAP) { atomicAdd(&bar[XB_TMO], 1u); break; } }
    }
    nloc = mine > 0u ? mine : 1u; nx = cnt > 0u ? cnt : 1u;
}

__device__ __forceinline__ void xcd_barrier(const XcdBarrier& b) {
    asm volatile("s_waitcnt vmcnt(0)" ::: "memory");
    __syncthreads();
    if (threadIdx.x == 0) {
        unsigned* bar = b.bar;
        __builtin_amdgcn_s_waitcnt(0);
        unsigned nloc = b.st[0], nx = b.st[1];
        if (nloc == 0u) { xcd_barrier_complete(bar, b.x, nloc, nx); b.st[0] = nloc; b.st[1] = nx; }
        const unsigned old = xb_add(&bar[XB_XSUB(b.x)], 1u);
        const unsigned gen = old / nloc;
        if (old + 1u == (gen + 1u) * nloc) {
            __builtin_amdgcn_fence(__ATOMIC_RELEASE, "agent");
            asm volatile("s_waitcnt vmcnt(0)" ::: "memory");
            const unsigned og = xb_add(&bar[XB_TOP], 1u);
            const unsigned tg = og / nx;
            if (og + 1u == (tg + 1u) * nx) xb_add(&bar[XB_TOPGEN], 1u);
            else XB_SPIN(xb_ld(&bar[XB_TOPGEN]) == tg, bar);
            __builtin_amdgcn_fence(__ATOMIC_ACQUIRE, "agent");
            xb_add(&bar[XB_XGEN(b.x)], 1u);
            asm volatile("s_waitcnt vmcnt(0)" ::: "memory");
        } else {
            XB_SPIN(xb_ld(&bar[XB_XGEN(b.x)]) == gen, bar);
            __builtin_amdgcn_fence(__ATOMIC_ACQUIRE, "agent");
            asm volatile("s_waitcnt vmcnt(0)" ::: "memory");
        }
    }
    __syncthreads();
}

__global__ void __launch_bounds__(NWAVES * 64, 2) mega_fwd(Args a) {
    extern __shared__ __attribute__((aligned(16))) unsigned char lds_raw[];
    LAS unsigned char* lds = (LAS unsigned char*)lds_raw;
    cg::grid_group grid = cg::this_grid();
    const int tid = threadIdx.x, lane = tid & 63, wave = __builtin_amdgcn_readfirstlane(tid >> 6);
    const int G = gridDim.x, bx = blockIdx.x;
    const int vcu = (G % 8 == 0) ? (bx % 8) * (G / 8) + bx / 8 : bx;
    const int gw = vcu * NWAVES + wave, NGW = G * NWAVES;
    unsigned char* ws = a.ws;
    const float* x_in = a.in[0]; float* xo = a.out;
    volatile LAS unsigned* MISC = (volatile LAS unsigned*)(lds + 131072 + 320);
    if (tid < 32) MISC[tid] = 0u;
    __syncthreads();
    bf16_t* Wglu = (bf16_t*)(ws + WS_WGLU); bf16_t* Wqkv = (bf16_t*)(ws + WS_WQKV); bf16_t* Wo = (bf16_t*)(ws + WS_WO);
    bf16_t* Wgu0 = (bf16_t*)(ws + WS_WGU0); bf16_t* Wgu1 = (bf16_t*)(ws + WS_WGU1); bf16_t* Wd0 = (bf16_t*)(ws + WS_WD0); bf16_t* Wd1 = (bf16_t*)(ws + WS_WD1);
    bf16_t* X1 = (bf16_t*)a.out;
    float* RS1 = (float*)ws; float* RS2 = RS1 + MTOK; float* RS3 = RS2 + MTOK;
    bf16_t* XN = (bf16_t*)(ws + WS_XN); bf16_t* HB = (bf16_t*)(ws + WS_BIG); bf16_t* Q0 = (bf16_t*)(ws + WS_Q0); bf16_t* KB = (bf16_t*)(ws + WS_K);

    {
        LAS float* scr = (LAS float*)(lds + wave * 16384);
        constexpr int I_GLU = 32 * 64, I_Q = 32 * 96, I_KV = 32 * 64, I_O = 32 * 32, I_GU = 32 * 176, I_D = 88 * 32;
        constexpr int NITEMS = I_GLU + I_Q + I_KV + I_O + 2 * I_GU + 2 * I_D;
        for (int it = gw; it < NITEMS; it += NGW) {
            int r = it;
            if (r < I_GLU) { p0_item64(a.in[11], DM, 2 * DM, nullptr, Wglu, r, 1, DM, 0, scr, lane); continue; } r -= I_GLU;
            if (r < I_Q) { p0_item64(a.in[15], DM, 3 * DM, a.in[1] + DM, Wqkv, r, 0, 0, 0, scr, lane); continue; } r -= I_Q;
            if (r < I_KV) { p0_item64(a.in[13], DM, 2 * DM, a.in[12], Wqkv, r, 0, 0, 3 * DM, scr, lane); continue; } r -= I_KV;
            if (r < I_O) { p0_item64(a.in[17], DM, DM, nullptr, Wo, r, 0, 0, 0, scr, lane); continue; } r -= I_O;
            if (r < I_GU) { p0_item64(a.in[18], DM, 2 * DFF, a.in[2], Wgu0, r, 1, DFF, 0, scr, lane); continue; } r -= I_GU;
            if (r < I_GU) { p0_item64(a.in[18] + (size_t)DM * 2 * DFF, DM, 2 * DFF, a.in[2] + DM, Wgu1, r, 1, DFF, 0, scr, lane); continue; } r -= I_GU;
            if (r < I_D) { p0_item64(a.in[19], DFF, DM, nullptr, Wd0, r, 0, 0, 0, scr, lane); continue; } r -= I_D;
            p0_item64(a.in[19] + (size_t)DFF * DM, DFF, DM, nullptr, Wd1, r, 0, 0, 0, scr, lane);
        }
        for (int i = gw * 64 + lane; i < 3 * MTOK; i += NGW * 64) RS1[i] = 0.f;
        if (bx == 0) for (int i = tid; i < XCD_BAR_WORDS; i += NWAVES * 64) ((unsigned*)(ws + WS_BAR))[i] = 0u;
        bf16_t* U = (bf16_t*)(ws + WS_U);
        for (int m = gw; m < MTOK; m += 2 * NGW) {
            const int m2 = m + NGW; const f32x4* xa = (const f32x4*)(x_in + (size_t)m * DM) + lane; const f32x4* xb = (const f32x4*)(x_in + (size_t)m2 * DM) + lane;
            f32x4 va[8], vb[8]; float sa = 0.f, sb = 0.f;
#pragma unroll
            for (int j = 0; j < 8; ++j) va[j] = xa[64 * j];
#pragma unroll
            for (int j = 0; j < 8; ++j) vb[j] = xb[64 * j];
#pragma unroll
            for (int j = 0; j < 8; ++j) { sa += (va[j].x * va[j].x + va[j].y * va[j].y) + (va[j].z * va[j].z + va[j].w * va[j].w); sb += (vb[j].x * vb[j].x + vb[j].y * vb[j].y) + (vb[j].z * vb[j].z + vb[j].w * vb[j].w); }
            const float ra = 1.0f / sqrtf(wave_sum(sa) * (1.f / DM) + EPS), rb = 1.0f / sqrtf(wave_sum(sb) * (1.f / DM) + EPS);
            u32x2* oa = (u32x2*)(U + (size_t)m * DM) + lane; u32x2* ob = (u32x2*)(U + (size_t)m2 * DM) + lane;
#pragma unroll
            for (int j = 0; j < 8; ++j) { const f32x4 g = ((const f32x4*)a.in[1])[lane + 64 * j];
                u32x2 w; w.x = cvtpk(va[j].x * ra * g.x, va[j].y * ra * g.y); w.y = cvtpk(va[j].z * ra * g.z, va[j].w * ra * g.w); oa[64 * j] = w;
                w.x = cvtpk(vb[j].x * rb * g.x, vb[j].y * rb * g.y); w.y = cvtpk(vb[j].z * rb * g.z, vb[j].w * rb * g.w); ob[64 * j] = w; }
        }
    }
    grid.sync();
    const XcdBarrier xbar = xcd_barrier_post((unsigned*)(ws + WS_BAR), MISC + 8);
    for (int t = gw; t < SG * (NCH - 1); t += NGW) s5_task<false>(a, t % SG, t / SG, lds + wave * 10240, lane);
    xcd_barrier(xbar);
    for (int t = gw; t < SG * NCH; t += NGW) s5_task<true>(a, t % SG, t / SG, lds + wave * 10240, lane);
    xcd_barrier(xbar);
    { pg8::Gemm g{XN, Wglu, MTOK, 2 * DM, DM}; pg8::StaticOrder S; S.init(MTOK, 2 * DM, G, bx); pg8::EpiGluRes2 E{x_in, X1, RS1, DM};
      pg8::gemm_phase<pg8::EpiGluRes2, pg8::StaticOrder, true, true>(lds, g, S, E); }
    xcd_barrier(xbar);
    { pg8::Gemm g{X1, Wgu0, MTOK, 2 * DFF, DM}; pg8::StaticOrder S; S.init(MTOK, 2 * DFF, G, bx); pg8::EpiSwiglu2 E{HB, DFF, RS1, 1.f / DM, EPS};
      pg8::gemm_phase<pg8::EpiSwiglu2, pg8::StaticOrder, true, true>(lds, g, S, E); }
    xcd_barrier(xbar);
    { pg8::Gemm g{HB, Wd0, MTOK, DM, DFF}; pg8::StaticOrder S; S.init(MTOK, DM, G, bx); pg8::EpiResAddBf E{X1, XN, RS2, DM};
      pg8::gemm_phase<pg8::EpiResAddBf, pg8::StaticOrder, true, true>(lds, g, S, E); }
    xcd_barrier(xbar);
    { pg8::Gemm g{XN, Wqkv, MTOK, 5 * DM, DM}; pg8::StaticOrder S; S.init(MTOK, 5 * DM, G, bx); pg8::EpiQKV E{Q0, QKV_T, SEQ, HP, RS2, 1.f / DM, EPS, (PG8_LAS float*)(lds + LDS_STG), a.in[14]};
      pg8::gemm_phase<pg8::EpiQKV, pg8::StaticOrder, true, true>(lds, g, S, E); }
    xcd_barrier(xbar);
    for (int su = vcu; su < BATCH * NHEAD * (SEQ / 2048); su += G) {
        const int b = su / (NHEAD * 8), head = (su / 8) % NHEAD, Ts = (su % 8) * 2048;
        attn_shared(a, b, head, Ts, wave, lds, lane);
        __syncthreads();
    }
    xcd_barrier(xbar);
    { pg8::Gemm g{X1, Wo, MTOK, DM, DM}; pg8::StaticOrder S; S.init(MTOK, DM, G, bx); pg8::EpiResAddBf E{XN, XN, RS3, DM};
      pg8::gemm_phase<pg8::EpiResAddBf, pg8::StaticOrder, true, true>(lds, g, S, E); }
    xcd_barrier(xbar);
    { pg8::Gemm g{XN, Wgu1, MTOK, 2 * DFF, DM}; pg8::StaticOrder S; S.init(MTOK, 2 * DFF, G, bx); pg8::EpiSwiglu2 E{HB, DFF, RS3, 1.f / DM, EPS};
      pg8::gemm_phase<pg8::EpiSwiglu2, pg8::StaticOrder, true, true>(lds, g, S, E); }
    xcd_barrier(xbar);
    { pg8::Gemm g{HB, Wd1, MTOK, DM, DFF}; pg8::StaticOrder S; S.init(MTOK, DM, G, bx); pg8::EpiResAddF32 E{XN, xo, DM};
      pg8::gemm_phase<pg8::EpiResAddF32, pg8::StaticOrder, true, true>(lds, g, S, E); }
}

extern "C" void kernel_launch(void* const* d_in, const int* in_sizes, int n_in, void* d_out, int out_size, void* d_ws, size_t ws_size, hipStream_t stream) {
    static int grid = 0;
    if (grid == 0) {
        if (n_in != 20 || out_size != MTOK * DM || ws_size < WS_END) { fprintf(stderr, "kernel_launch: unexpected problem (n_in %d out %d ws %zu)\n", n_in, out_size, ws_size); grid = -1; return; }
        int dev = 0, cus = 0, per_cu = 0;
        hipGetDevice(&dev); hipDeviceGetAttribute(&cus, hipDeviceAttributeMultiprocessorCount, dev);
        if (hipFuncSetAttribute((const void*)mega_fwd, hipFuncAttributeMaxDynamicSharedMemorySize, LDS_BYTES) != hipSuccess) { fprintf(stderr, "kernel_launch: hipFuncSetAttribute failed\n"); grid = -1; return; }
        if (hipOccupancyMaxActiveBlocksPerMultiprocessor(&per_cu, (const void*)mega_fwd, NWAVES * 64, LDS_BYTES) != hipSuccess || per_cu < 1) { fprintf(stderr, "kernel_launch: occupancy query says %d\n", per_cu); per_cu = 1; }
        (void)hipGetLastError();
        grid = cus * 1;
    }
    if (grid < 0) return;
    Args a{};
    for (int i = 0; i < 20; ++i) a.in[i] = (const float*)d_in[i];
    a.out = (float*)d_out; a.ws = (unsigned char*)d_ws;
    void* args[] = {&a};
    hipError_t e = hipLaunchCooperativeKernel((const void*)mega_fwd, dim3(grid), dim3(NWAVES * 64), args, LDS_BYTES, stream);
    if (e != hipSuccess) fprintf(stderr, "kernel_launch: cooperative launch failed: %s (grid %d)\n", hipGetErrorString(e), grid);
}
```

```cpp
#include <hip/hip_runtime.h>
#include <hip/hip_cooperative_groups.h>
#include <cstdio>
#include <cstdint>
#include <cmath>
namespace cg = cooperative_groups;
namespace pg8 {
#define PG8_LAS __attribute__((address_space(3)))
typedef unsigned short bf16_t;
typedef short bf16x8 __attribute__((ext_vector_type(8)));
typedef float f32x4 __attribute__((ext_vector_type(4)));
typedef unsigned u32x4 __attribute__((ext_vector_type(4)));
constexpr int BM = 256, BK = 64, HALF = 128, HTB = HALF * BK * 2  , STAGE_BYTES = 8 * HTB, NXCD = 8, WGM = 4;

__host__ __device__ __forceinline__ int lds_byte(int r, int c) { const int st = (r >> 4) * 2 + (c >> 5), rr = r & 15, cc = c & 31, ob = rr * 64 + cc * 2; return st * 1024 + (ob ^ (((ob >> 9) & 1) << 5)); }
__host__ __device__ __forceinline__ void stage_rc(int b, int& R, int& C) { const int st = b / 1024, sb = b % 1024, swz = sb ^ (((sb >> 9) & 1) << 5); R = (st >> 1) * 16 + swz / 64; C = (st & 1) * 32 + (swz % 64) / 2; }
__host__ __device__ __forceinline__ int perm32(int rho) { const int n = rho >> 4, i = rho & 15; return 8 * (i >> 2) + 4 * n + (i & 3); }

struct Unit { int pm, pn; };
struct Gemm { const bf16_t* A; const bf16_t* Bt; int M, N, K; };

struct StaticOrder {
    int nM, nN, nwg, G, c;
    __host__ __device__ void init(int M, int N, int G_, int c_) { nM = M / BM; nN = N / BM; nwg = nM * nN; G = G_; c = c_; }
    __host__ __device__ bool next(int i, Unit& u) const {
        const long L = (long)i * G + c; if (L >= nwg) return false;
        int wgid = (int)L; { const int q = nwg / NXCD, r = nwg % NXCD, xcd = wgid % NXCD, off = wgid / NXCD; wgid = (xcd < r ? xcd * (q + 1) : r * (q + 1) + (xcd - r) * q) + off; }
        const int nig = WGM * nN, gid = wgid / nig, fm = gid * WGM, gsz = (nM - fm) < WGM ? (nM - fm) : WGM;
        u.pm = fm + ((wgid % nig) % gsz); u.pn = (wgid % nig) / gsz; return true;
    }
    __device__ __forceinline__ void a_ready(const Unit&) const {}
    __device__ __forceinline__ void done(const Unit&) const {}
};

__device__ __forceinline__ unsigned cvt_pk_bf16(float lo, float hi) { unsigned r; asm volatile("v_cvt_pk_bf16_f32 %0, %1, %2" : "=v"(r) : "v"(lo), "v"(hi)); return r; }
typedef float f32x2 __attribute__((ext_vector_type(2)));
__device__ __forceinline__ f32x2 gelu_pk(f32x2 v) {
    const f32x2 av = __builtin_elementwise_abs(v), d = av * 0.2316418882f + 1.0f;
    f32x2 t; t.x = __builtin_amdgcn_rcpf(d.x); t.y = __builtin_amdgcn_rcpf(d.y);
    f32x2 q = t * 0.5307027145f + (-0.7265760135f); q = q * t + 0.7107068705f; q = q * t + (-0.142248368f); q = q * t + 0.127414796f; q = q * t;
    const f32x2 s = (v * v) * (-0.72134752044f);
    f32x2 e; e.x = __builtin_amdgcn_exp2f(s.x); e.y = __builtin_amdgcn_exp2f(s.y);
    const f32x2 m = v * (q * e), r = v - m;
    f32x2 o; o.x = v.x < 0.f ? m.x : r.x; o.y = v.y < 0.f ? m.y : r.y; return o;
}

template <int ACT  > struct EpiBf16 {
    static constexpr bool PERM = true, AFTER_DRAIN = false; static_assert(ACT == 0 || ACT == 1, "EpiBf16: ACT is 0 (none) or 1 (gelu_pk)");
    bf16_t* O; int ldc; const float* bias; int split_cols; size_t split_stride; float scale0;
    __device__ __forceinline__ void operator()(const f32x4 (&acc)[2][2][4][2], const Unit& u, int wr, int wc, int fr, int fq) const {
        const int row0 = u.pm * BM + wr * 64 + fr; int colt = u.pn * BM; bf16_t* base = O;
        float sc = 1.f; if (split_cols) { const int t = colt / split_cols; base += (size_t)t * split_stride; colt -= t * split_cols; if (t == 0) sc = scale0; }
        const int col0 = colt + wc * 32 + 8 * fq, bcol0 = u.pn * BM + wc * 32 + 8 * fq;
        f32x4 bv[2][2];
#pragma unroll
        for (int bj = 0; bj < 2; ++bj)
#pragma unroll
            for (int n = 0; n < 2; ++n) bv[bj][n] = bias ? *(const f32x4*)(bias + bcol0 + bj * HALF + 4 * n) : (f32x4){0.f, 0.f, 0.f, 0.f};
#pragma unroll
        for (int ai = 0; ai < 2; ++ai)
#pragma unroll
            for (int m = 0; m < 4; ++m) { bf16_t* rowp = base + (size_t)(row0 + ai * HALF + m * 16) * ldc + col0;
#pragma unroll
                for (int bj = 0; bj < 2; ++bj) { f32x4 v0 = acc[ai][bj][m][0] + bv[bj][0], v1 = acc[ai][bj][m][1] + bv[bj][1];
                    if (ACT == 1) { f32x2 a = gelu_pk((f32x2){v0[0], v0[1]}), b = gelu_pk((f32x2){v0[2], v0[3]}), c = gelu_pk((f32x2){v1[0], v1[1]}), d = gelu_pk((f32x2){v1[2], v1[3]});
                        v0 = (f32x4){a.x, a.y, b.x, b.y}; v1 = (f32x4){c.x, c.y, d.x, d.y}; }
                    v0 = v0 * sc; v1 = v1 * sc; u32x4 w; w.x = cvt_pk_bf16(v0[0], v0[1]); w.y = cvt_pk_bf16(v0[2], v0[3]); w.z = cvt_pk_bf16(v1[0], v1[1]); w.w = cvt_pk_bf16(v1[2], v1[3]);
                    *(u32x4*)(rowp + bj * HALF) = w; } }
    }
};
typedef unsigned u32x2e __attribute__((ext_vector_type(2)));
__device__ __forceinline__ float sigmoid_f(float x) { return __builtin_amdgcn_rcpf(1.0f + __builtin_amdgcn_exp2f(-1.4426950408889634f * x)); }
struct EpiGluRes {
    static constexpr bool PERM = true, AFTER_DRAIN = false;
    const float* resid; float* out; int ldc;
    __device__ __forceinline__ void operator()(const f32x4 (&acc)[2][2][4][2], const Unit& u, int wr, int wc, int fr, int fq) const {
        const int row0 = u.pm * BM + wr * 64 + fr, col0 = u.pn * HALF + wc * 32 + 8 * fq;
#pragma unroll
        for (int ai = 0; ai < 2; ++ai)
#pragma unroll
            for (int m = 0; m < 4; ++m) { const size_t off = (size_t)(row0 + ai * HALF + m * 16) * ldc + col0;
#pragma unroll
                for (int n = 0; n < 2; ++n) { const f32x4 r = *(const f32x4*)(resid + off + 4 * n); const f32x4 v = acc[ai][0][m][n], g = acc[ai][1][m][n]; f32x4 o;
                    o[0] = r[0] + v[0] * sigmoid_f(g[0]); o[1] = r[1] + v[1] * sigmoid_f(g[1]); o[2] = r[2] + v[2] * sigmoid_f(g[2]); o[3] = r[3] + v[3] * sigmoid_f(g[3]);
                    *(f32x4*)(out + off + 4 * n) = o; } }
    }
};
struct EpiSwiglu {
    static constexpr bool PERM = true, AFTER_DRAIN = false;
    bf16_t* O; int ldc;
    __device__ __forceinline__ void operator()(const f32x4 (&acc)[2][2][4][2], const Unit& u, int wr, int wc, int fr, int fq) const {
        const int row0 = u.pm * BM + wr * 64 + fr, col0 = u.pn * HALF + wc * 32 + 8 * fq;
#pragma unroll
        for (int ai = 0; ai < 2; ++ai)
#pragma unroll
            for (int m = 0; m < 4; ++m) { bf16_t* rowp = O + (size_t)(row0 + ai * HALF + m * 16) * ldc + col0;
                float h[8];
#pragma unroll
                for (int n = 0; n < 2; ++n)
#pragma unroll
                    for (int e = 0; e < 4; ++e) { const float g = acc[ai][0][m][n][e], up = acc[ai][1][m][n][e]; h[4 * n + e] = g * sigmoid_f(g) * up; }
                u32x4 w; w.x = cvt_pk_bf16(h[0], h[1]); w.y = cvt_pk_bf16(h[2], h[3]); w.z = cvt_pk_bf16(h[4], h[5]); w.w = cvt_pk_bf16(h[6], h[7]);
                *(u32x4*)rowp = w; }
    }
};
struct EpiResAdd {
    static constexpr bool PERM = true, AFTER_DRAIN = false;
    const float* resid; float* out; int ldc;
    __device__ __forceinline__ void operator()(const f32x4 (&acc)[2][2][4][2], const Unit& u, int wr, int wc, int fr, int fq) const {
        const int row0 = u.pm * BM + wr * 64 + fr, col0 = u.pn * BM + wc * 32 + 8 * fq;
#pragma unroll
        for (int ai = 0; ai < 2; ++ai)
#pragma unroll
            for (int m = 0; m < 4; ++m) { const size_t off = (size_t)(row0 + ai * HALF + m * 16) * ldc + col0;
#pragma unroll
                for (int bj = 0; bj < 2; ++bj)
#pragma unroll
                    for (int n = 0; n < 2; ++n) { const f32x4 r = *(const f32x4*)(resid + off + bj * HALF + 4 * n); *(f32x4*)(out + off + bj * HALF + 4 * n) = r + acc[ai][bj][m][n]; } }
    }
};

__device__ __forceinline__ float bfl(unsigned w) { return __builtin_bit_cast(float, w << 16); }
__device__ __forceinline__ float bfh(unsigned w) { return __builtin_bit_cast(float, w & 0xffff0000u); }
__device__ __forceinline__ void ss_add(float* ss, int row, float s, int fq) {
    s += __shfl_xor(s, 16); s += __shfl_xor(s, 32);
    if (fq == 0) __hip_atomic_fetch_add(ss + row, s, __ATOMIC_RELAXED, __HIP_MEMORY_SCOPE_AGENT);
}
struct EpiGluRes2 {
    static constexpr bool PERM = true, AFTER_DRAIN = false;
    const float* resid; bf16_t* out; float* ss; int ldc;
    __device__ __forceinline__ void operator()(const f32x4 (&acc)[2][2][4][2], const Unit& u, int wr, int wc, int fr, int fq) const {
        const int row0 = u.pm * BM + wr * 64 + fr, col0 = u.pn * HALF + wc * 32 + 8 * fq;
#pragma unroll
        for (int ai = 0; ai < 2; ++ai)
#pragma unroll
            for (int m = 0; m < 4; ++m) { const int row = row0 + ai * HALF + m * 16; const size_t off = (size_t)row * ldc + col0; float o[8]; float s = 0.f;
#pragma unroll
                for (int n = 0; n < 2; ++n) { const f32x4 r = *(const f32x4*)(resid + off + 4 * n); const f32x4 v = acc[ai][0][m][n], g = acc[ai][1][m][n];
#pragma unroll
                    for (int e = 0; e < 4; ++e) { const float x = r[e] + v[e] * sigmoid_f(g[e]); o[4 * n + e] = x; s += x * x; } }
                u32x4 w; w.x = cvt_pk_bf16(o[0], o[1]); w.y = cvt_pk_bf16(o[2], o[3]); w.z = cvt_pk_bf16(o[4], o[5]); w.w = cvt_pk_bf16(o[6], o[7]);
                *(u32x4*)(out + off) = w; ss_add(ss, row, s, fq); }
    }
};
struct EpiResAddBf {
    static constexpr bool PERM = true, AFTER_DRAIN = false;
    const bf16_t* resid; bf16_t* out; float* ss; int ldc;
    __device__ __forceinline__ void operator()(const f32x4 (&acc)[2][2][4][2], const Unit& u, int wr, int wc, int fr, int fq) const {
        const int row0 = u.pm * BM + wr * 64 + fr, col0 = u.pn * BM + wc * 32 + 8 * fq;
#pragma unroll
        for (int ai = 0; ai < 2; ++ai)
#pragma unroll
            for (int m = 0; m < 4; ++m) { const int row = row0 + ai * HALF + m * 16; const size_t off = (size_t)row * ldc + col0; float s = 0.f;
#pragma unroll
                for (int bj = 0; bj < 2; ++bj) { const u32x4 r = *(const u32x4*)(resid + off + bj * HALF); const f32x4 a0 = acc[ai][bj][m][0], a1 = acc[ai][bj][m][1];
                    const float o0 = bfl(r.x) + a0[0], o1 = bfh(r.x) + a0[1], o2 = bfl(r.y) + a0[2], o3 = bfh(r.y) + a0[3], o4 = bfl(r.z) + a1[0], o5 = bfh(r.z) + a1[1], o6 = bfl(r.w) + a1[2], o7 = bfh(r.w) + a1[3];
                    s += (o0 * o0 + o1 * o1) + (o2 * o2 + o3 * o3) + (o4 * o4 + o5 * o5) + (o6 * o6 + o7 * o7);
                    u32x4 w; w.x = cvt_pk_bf16(o0, o1); w.y = cvt_pk_bf16(o2, o3); w.z = cvt_pk_bf16(o4, o5); w.w = cvt_pk_bf16(o6, o7);
                    *(u32x4*)(out + off + bj * HALF) = w; }
                ss_add(ss, row, s, fq); }
    }
};
struct EpiResAddF32 {
    static constexpr bool PERM = true, AFTER_DRAIN = false;
    const bf16_t* resid; float* out; int ldc;
    __device__ __forceinline__ void operator()(const f32x4 (&acc)[2][2][4][2], const Unit& u, int wr, int wc, int fr, int fq) const {
        const int row0 = u.pm * BM + wr * 64 + fr, col0 = u.pn * BM + wc * 32 + 8 * fq;
#pragma unroll
        for (int ai = 0; ai < 2; ++ai)
#pragma unroll
            for (int m = 0; m < 4; ++m) { const size_t off = (size_t)(row0 + ai * HALF + m * 16) * ldc + col0;
#pragma unroll
                for (int bj = 0; bj < 2; ++bj) { const u32x4 r = *(const u32x4*)(resid + off + bj * HALF); const f32x4 a0 = acc[ai][bj][m][0], a1 = acc[ai][bj][m][1];
                    *(f32x4*)(out + off + bj * HALF) = (f32x4){bfl(r.x) + a0[0], bfh(r.x) + a0[1], bfl(r.y) + a0[2], bfh(r.y) + a0[3]};
                    *(f32x4*)(out + off + bj * HALF + 4) = (f32x4){bfl(r.z) + a1[0], bfh(r.z) + a1[1], bfl(r.w) + a1[2], bfh(r.w) + a1[3]}; } }
    }
};
struct EpiSwiglu2 {
    static constexpr bool PERM = true, AFTER_DRAIN = false;
    bf16_t* O; int ldc; const float* ss; float inv_n, eps;
    __device__ __forceinline__ void operator()(const f32x4 (&acc)[2][2][4][2], const Unit& u, int wr, int wc, int fr, int fq) const {
        const int row0 = u.pm * BM + wr * 64 + fr, col0 = u.pn * HALF + wc * 32 + 8 * fq;
#pragma unroll
        for (int ai = 0; ai < 2; ++ai)
#pragma unroll
            for (int m = 0; m < 4; ++m) { const int row = row0 + ai * HALF + m * 16; bf16_t* rowp = O + (size_t)row * ldc + col0; const float rs = __builtin_amdgcn_rsqf(ss[row] * inv_n + eps);
                float h[8];
#pragma unroll
                for (int n = 0; n < 2; ++n)
#pragma unroll
                    for (int e = 0; e < 4; ++e) { const float g = acc[ai][0][m][n][e] * rs, up = acc[ai][1][m][n][e] * rs; h[4 * n + e] = g * sigmoid_f(g) * up; }
                u32x4 w; w.x = cvt_pk_bf16(h[0], h[1]); w.y = cvt_pk_bf16(h[2], h[3]); w.z = cvt_pk_bf16(h[4], h[5]); w.w = cvt_pk_bf16(h[6], h[7]);
                *(u32x4*)rowp = w; }
    }
};

struct EpiQKV {
    static constexpr bool PERM = true, AFTER_DRAIN = false;
    bf16_t* base; size_t tstride; int seq, pitch; const float* ss; float inv_n, eps; PG8_LAS float* kscr; const float* kgain;
    __device__ __forceinline__ void operator()(const f32x4 (&acc)[2][2][4][2], const Unit& u, int wr, int wc, int fr, int fq) const {
        const int colt = u.pn * BM, t = colt >> 11, head0 = (colt & 2047) >> 7, d = wc * 32 + 8 * fq;
        const int rowt = u.pm * BM, b = rowt / seq, tok0 = rowt - b * seq + wr * 64 + fr;
        bf16_t* tb = base + (size_t)t * tstride;
        const bool isk = (t == 3);
        float rs[2][4];
#pragma unroll
        for (int ai = 0; ai < 2; ++ai)
#pragma unroll
            for (int m = 0; m < 4; ++m) rs[ai][m] = __builtin_amdgcn_rsqf(ss[rowt + wr * 64 + fr + ai * HALF + m * 16] * inv_n + eps);
        f32x4 kg0 = {1.f, 1.f, 1.f, 1.f}, kg1 = {1.f, 1.f, 1.f, 1.f};
        if (isk) {
            kg0 = *(const f32x4*)(kgain + d); kg1 = *(const f32x4*)(kgain + d + 4);
#pragma unroll
            for (int bj = 0; bj < 2; ++bj)
#pragma unroll
                for (int ai = 0; ai < 2; ++ai)
#pragma unroll
                    for (int m = 0; m < 4; ++m) { const f32x4 v0 = acc[ai][bj][m][0] * rs[ai][m], v1 = acc[ai][bj][m][1] * rs[ai][m];
                        float s = (v0[0] * v0[0] + v0[1] * v0[1]) + (v0[2] * v0[2] + v0[3] * v0[3]) + (v1[0] * v1[0] + v1[1] * v1[1]) + (v1[2] * v1[2] + v1[3] * v1[3]);
                        s += __shfl_xor(s, 16); s += __shfl_xor(s, 32);
                        if (fq == 0) kscr[((ai * HALF + wr * 64 + m * 16 + fr) * 2 + bj) * 4 + wc] = s; }
            asm volatile("s_waitcnt lgkmcnt(0)" ::: "memory"); __builtin_amdgcn_s_barrier(); asm volatile("" ::: "memory");
        }
#pragma unroll
        for (int bj = 0; bj < 2; ++bj) { bf16_t* hb = tb + ((size_t)(b * 16 + head0 + bj) * seq) * pitch + d;
#pragma unroll
            for (int ai = 0; ai < 2; ++ai)
#pragma unroll
                for (int m = 0; m < 4; ++m) { float sc = rs[ai][m];
                    if (isk) { const f32x4 p = *(const PG8_LAS f32x4*)(kscr + ((ai * HALF + wr * 64 + m * 16 + fr) * 2 + bj) * 4); sc *= __builtin_amdgcn_rsqf(((p[0] + p[1]) + (p[2] + p[3])) * (1.0f / 128.0f) + eps); }
                    const f32x4 v0 = acc[ai][bj][m][0] * sc * kg0, v1 = acc[ai][bj][m][1] * sc * kg1;
                    u32x4 w; w.x = cvt_pk_bf16(v0[0], v0[1]); w.y = cvt_pk_bf16(v0[2], v0[3]); w.z = cvt_pk_bf16(v1[0], v1[1]); w.w = cvt_pk_bf16(v1[2], v1[3]);
                    *(u32x4*)(hb + (size_t)(tok0 + ai * HALF + m * 16) * pitch) = w; } }
    }
};
template <class Epi, class Sched, bool ALIGN_EPI = false, bool SP2 = false>
__device__ __forceinline__ void gemm_phase(PG8_LAS unsigned char* lds, const Gemm g, const Sched& S, const Epi& E) {
    int tid_ = threadIdx.x; asm volatile("" : "+v"(tid_));
    const int tid = tid_, wid = __builtin_amdgcn_readfirstlane(tid >> 6), lane = tid & 63, wr = wid >> 2, wc = wid & 3, fr = lane & 15, fq = lane >> 4;
    const int K = g.K, nt = K / BK;
    unsigned voffA[2], voffB[2];
#pragma unroll
    for (int i = 0; i < 2; ++i) { int R, C; stage_rc(tid * 16 + i * 8192, R, C); const int Rb = Epi::PERM ? ((R & ~31) + perm32(R & 31)) : R;
        voffA[i] = (unsigned)(R * K + C) * 2u; voffB[i] = (unsigned)(Rb * K + C) * 2u; }
    const size_t kstep = (size_t)(BK * 2);
    const size_t hstep = (size_t)HALF * K * 2;
    const size_t tstep = 2 * hstep;
    const unsigned ldsw = (unsigned)wid * 1024u;
    const int aoff = lds_byte(wr * 64 + fr, fq * 8), boff = lds_byte(wc * 32 + fr, fq * 8);
#define PG8_SA(b, h) (((b) * 2 + (h)) * HTB)
#define PG8_SB(b, h) ((4 + (b) * 2 + (h)) * HTB)
#define PG8_STAGE(bufoff, gbase, voff) do { _Pragma("unroll") for (int _i = 0; _i < 2; ++_i) \
        __builtin_amdgcn_global_load_lds((const unsigned*)((const char*)(gbase) + (voff)[_i]), (PG8_LAS unsigned*)(lds + (bufoff) + ldsw + _i * 8192), 16, 0, 0); } while (0)
#define PG8_LDA(dst, b, h) do { _Pragma("unroll") for (int m = 0; m < 4; ++m) _Pragma("unroll") for (int k = 0; k < 2; ++k) dst[m][k] = *(const PG8_LAS bf16x8*)(lds + PG8_SA(b, h) + aoff + m * 2048 + k * 1024); } while (0)
#define PG8_LDB(dst, b, h) do { _Pragma("unroll") for (int n = 0; n < 2; ++n) _Pragma("unroll") for (int k = 0; k < 2; ++k) dst[n][k] = *(const PG8_LAS bf16x8*)(lds + PG8_SB(b, h) + boff + n * 2048 + k * 1024); } while (0)
#define PG8_MMA(ai, bj, At, Bt) do { __builtin_amdgcn_s_setprio(1); _Pragma("unroll") for (int m = 0; m < 4; ++m) _Pragma("unroll") for (int n = 0; n < 2; ++n) _Pragma("unroll") for (int k = 0; k < 2; ++k) \
        acc[ai][bj][m][n] = __builtin_amdgcn_mfma_f32_16x16x32_bf16(Bt[n][k], At[m][k], acc[ai][bj][m][n], 0, 0, 0); __builtin_amdgcn_s_setprio(0); } while (0)
#define PG8_WAIT_V(n) asm volatile("s_waitcnt vmcnt(" #n ")" ::: "memory")
#define PG8_WAIT_L(n) asm volatile("s_waitcnt lgkmcnt(" #n ")" ::: "memory")
#define PG8_BAR __builtin_amdgcn_s_barrier()
#define PG8_SCHED __builtin_amdgcn_sched_barrier(0)
    Unit cur, nxt; int ui = 0;
    if (!S.next(0, cur)) return;
    f32x4 acc[2][2][4][2];
#pragma unroll
    for (int a = 0; a < 2; ++a)
#pragma unroll
        for (int b = 0; b < 2; ++b)
#pragma unroll
            for (int m = 0; m < 4; ++m)
#pragma unroll
                for (int n = 0; n < 2; ++n) acc[a][b][m][n] = (f32x4){0.f, 0.f, 0.f, 0.f};
    bf16x8 At[4][2], B0[2][2], B1[2][2];
    const char* cA = (const char*)g.A + (size_t)cur.pm * tstep; const char* cB = (const char*)g.Bt + (size_t)cur.pn * tstep;
    S.a_ready(cur);
    if constexpr (SP2) {
        PG8_STAGE(PG8_SB(0, 0), cB, voffB); PG8_STAGE(PG8_SB(0, 1), cB + hstep, voffB); PG8_STAGE(PG8_SA(0, 0), cA, voffA); PG8_STAGE(PG8_SA(0, 1), cA + hstep, voffA);
        if (wr == 1) PG8_BAR;
        PG8_WAIT_V(2); PG8_BAR;
        PG8_STAGE(PG8_SB(1, 0), cB + kstep, voffB); PG8_STAGE(PG8_SA(1, 0), cA + kstep, voffA); PG8_STAGE(PG8_SB(1, 1), cB + hstep + kstep, voffB);
        PG8_WAIT_V(6); PG8_BAR;
    } else {
        PG8_STAGE(PG8_SB(0, 0), cB, voffB); PG8_STAGE(PG8_SA(0, 0), cA, voffA); PG8_STAGE(PG8_SB(0, 1), cB + hstep, voffB); PG8_STAGE(PG8_SA(0, 1), cA + hstep, voffA);
        if (wr == 1) PG8_BAR;
        PG8_WAIT_V(4); PG8_BAR;
        PG8_STAGE(PG8_SB(1, 0), cB + kstep, voffB); PG8_STAGE(PG8_SA(1, 0), cA + kstep, voffA); PG8_STAGE(PG8_SB(1, 1), cB + hstep + kstep, voffB);
        PG8_WAIT_V(6); PG8_BAR;
    }
    for (;;) {
        const bool has_next = S.next(ui + 1, nxt);
        const char* nA = has_next ? (const char*)g.A + (size_t)nxt.pm * tstep : cA; const char* nB = has_next ? (const char*)g.Bt + (size_t)nxt.pn * tstep : cB;
        for (int t = 0; t < nt; t += 2) {
            const bool last = (t == nt - 2);
            const char* a1 = cA + (size_t)(t + 1) * kstep;
            const char* a2 = last ? nA : cA + (size_t)(t + 2) * kstep; const char* b2 = last ? nB : cB + (size_t)(t + 2) * kstep;
            const char* a3 = a2 + kstep; const char* b3 = b2 + kstep;
            if (last && has_next) S.a_ready(nxt);
            if constexpr (SP2) {
            PG8_LDB(B0, 0, 0); PG8_LDB(B1, 0, 1); PG8_SCHED; PG8_LDA(At, 0, 0); PG8_STAGE(PG8_SA(1, 1), a1 + hstep, voffA);
            PG8_WAIT_V(8); PG8_WAIT_L(0); PG8_BAR; PG8_MMA(0, 0, At, B0); PG8_MMA(0, 1, At, B1); PG8_BAR; PG8_SCHED;
            PG8_LDA(At, 0, 1); PG8_STAGE(PG8_SB(0, 0), b2, voffB); PG8_STAGE(PG8_SB(0, 1), b2 + hstep, voffB); PG8_STAGE(PG8_SA(0, 0), a2, voffA);
            PG8_WAIT_V(8); PG8_WAIT_L(0); PG8_BAR; PG8_MMA(1, 0, At, B0); PG8_MMA(1, 1, At, B1); PG8_BAR; PG8_SCHED;
            PG8_LDB(B0, 1, 0); PG8_LDB(B1, 1, 1); PG8_SCHED; PG8_LDA(At, 1, 0); PG8_STAGE(PG8_SA(0, 1), a2 + hstep, voffA);
            PG8_WAIT_V(8); PG8_WAIT_L(0); PG8_BAR; PG8_MMA(0, 0, At, B0); PG8_MMA(0, 1, At, B1); PG8_BAR; PG8_SCHED;
            PG8_LDA(At, 1, 1); PG8_STAGE(PG8_SB(1, 0), b3, voffB); PG8_STAGE(PG8_SB(1, 1), b3 + hstep, voffB); PG8_STAGE(PG8_SA(1, 0), a3, voffA);
            PG8_WAIT_V(8); PG8_WAIT_L(0); PG8_BAR; PG8_MMA(1, 0, At, B0); PG8_MMA(1, 1, At, B1); PG8_BAR; PG8_SCHED;
            } else {
            PG8_LDB(B0, 0, 0); PG8_SCHED; PG8_LDA(At, 0, 0); PG8_STAGE(PG8_SA(1, 1), a1 + hstep, voffA);
            PG8_WAIT_L(8); PG8_BAR; PG8_WAIT_L(0); PG8_MMA(0, 0, At, B0); PG8_BAR; PG8_SCHED;
            PG8_LDB(B1, 0, 1); PG8_STAGE(PG8_SB(0, 0), b2, voffB);
            PG8_BAR; PG8_WAIT_L(0); PG8_MMA(0, 1, At, B1); PG8_BAR;
            PG8_LDA(At, 0, 1); PG8_STAGE(PG8_SA(0, 0), a2, voffA);
            PG8_BAR; PG8_WAIT_L(0); PG8_MMA(1, 0, At, B0); PG8_BAR; PG8_SCHED;
            PG8_STAGE(PG8_SB(0, 1), b2 + hstep, voffB);
            PG8_WAIT_V(6); PG8_BAR; PG8_MMA(1, 1, At, B1); PG8_BAR;
            PG8_LDB(B0, 1, 0); PG8_SCHED; PG8_LDA(At, 1, 0); PG8_STAGE(PG8_SA(0, 1), a2 + hstep, voffA);
            PG8_WAIT_L(8); PG8_BAR; PG8_WAIT_L(0); PG8_MMA(0, 0, At, B0); PG8_BAR; PG8_SCHED;
            PG8_LDB(B1, 1, 1); PG8_STAGE(PG8_SB(1, 0), b3, voffB);
            PG8_BAR; PG8_WAIT_L(0); PG8_MMA(0, 1, At, B1); PG8_BAR;
            PG8_LDA(At, 1, 1); PG8_STAGE(PG8_SA(1, 0), a3, voffA);
            PG8_BAR; PG8_WAIT_L(0); PG8_MMA(1, 0, At, B0); PG8_BAR; PG8_SCHED;
            PG8_STAGE(PG8_SB(1, 1), b3 + hstep, voffB);
            PG8_WAIT_V(6); PG8_BAR; PG8_MMA(1, 1, At, B1); PG8_BAR;
            }
        }
        if constexpr (ALIGN_EPI) { if (wr == 0) PG8_BAR; }
        if constexpr (!Epi::AFTER_DRAIN) { E(acc, cur, wr, wc, fr, fq); S.done(cur); }
        if (!has_next) break;
#pragma unroll
        for (int a = 0; a < 2; ++a)
#pragma unroll
            for (int b = 0; b < 2; ++b)
#pragma unroll
                for (int m = 0; m < 4; ++m)
#pragma unroll
                    for (int n = 0; n < 2; ++n) acc[a][b][m][n] = (f32x4){0.f, 0.f, 0.f, 0.f};
        cur = nxt; cA = nA; cB = nB; ++ui;
        if constexpr (ALIGN_EPI) { if (wr == 1) PG8_BAR; }
    }
    PG8_WAIT_V(0);
    if constexpr (!ALIGN_EPI) { if (wr == 0) PG8_BAR; }
    PG8_BAR;
    if constexpr (Epi::AFTER_DRAIN) { E.fused(acc, cur, wr, wc, fr, fq, lds, wid, lane); S.done(cur); }
#undef PG8_SA
#undef PG8_SB
#undef PG8_STAGE
#undef PG8_LDA
#undef PG8_LDB
#undef PG8_MMA
#undef PG8_WAIT_V
#undef PG8_WAIT_L
#undef PG8_BAR
#undef PG8_SCHED
}
}

#define LAS __attribute__((address_space(3)))
typedef unsigned short bf16_t;
typedef short bf16x8 __attribute__((ext_vector_type(8)));
typedef short s16x4 __attribute__((ext_vector_type(4)));
typedef float f32x4 __attribute__((ext_vector_type(4)));
typedef float f32x16 __attribute__((ext_vector_type(16)));
typedef unsigned u32x4 __attribute__((ext_vector_type(4)));
typedef unsigned u32x2 __attribute__((ext_vector_type(2)));
typedef float f32x2_t __attribute__((ext_vector_type(2)));
typedef __bf16 bf16x2_t __attribute__((ext_vector_type(2)));

constexpr int BATCH = 2, SEQ = 16384, DM = 2048, MTOK = BATCH * SEQ, DFF = 5632;
constexpr int SG = 128, SP = 64, SH = 16, SCH = 256, NCH = SEQ / SCH;
constexpr int NHEAD = 16, HD = 128;
constexpr float EPS = 1e-6f;
constexpr int NWAVES = 8;
constexpr size_t MiB = 1u << 20;
constexpr size_t WS_WGLU = 4 * MiB, WS_WQKV = 20 * MiB, WS_WO = 60 * MiB, WS_WGU0 = 68 * MiB, WS_WGU1 = 112 * MiB, WS_WD0 = 156 * MiB, WS_WD1 = 178 * MiB;
constexpr int HP = 128;
constexpr size_t QKV_T = (size_t)BATCH * 16 * SEQ * HP;
constexpr size_t WS_XN = 200 * MiB, WS_BIG = 328 * MiB, WS_Q0 = WS_BIG, WS_Q1 = WS_BIG + 2 * QKV_T, WS_Q2 = WS_BIG + 4 * QKV_T, WS_K = WS_BIG + 6 * QKV_T, WS_V = WS_BIG + 8 * QKV_T;
constexpr size_t WS_LSE = 1008 * MiB, WS_END = 1012 * MiB;
constexpr size_t WS_U = WS_BIG, WS_SST = WS_BIG + 128 * MiB;
constexpr int LDS_BYTES = 157696;
constexpr int LDS_STG = 135168, STG_WAVE = 2816, STG_PITCH = 80;
constexpr size_t WS_BAR = 2 * MiB;

__device__ __forceinline__ unsigned cvtpk(float lo, float hi) { f32x2_t v = {lo, hi}; bf16x2_t b = __builtin_convertvector(v, bf16x2_t); return __builtin_bit_cast(unsigned, b); }
__device__ __forceinline__ float bf_lo(unsigned w) { return __builtin_bit_cast(float, w << 16); }
__device__ __forceinline__ float bf_hi(unsigned w) { return __builtin_bit_cast(float, w & 0xffff0000u); }
__device__ __forceinline__ float wave_sum(float v) {
#pragma unroll
    for (int o = 1; o < 64; o <<= 1) v += __shfl_xor(v, o);
    return v;
}
__device__ __forceinline__ int crow(int r, int h) { return (r & 3) + 8 * (r >> 2) + 4 * h; }

struct Args { const float* in[20]; float* out; unsigned char* ws; };

__device__ __forceinline__ void p0_item(const float* W, int K, int N, const float* gain, bf16_t* WT, int item, int mode, int Hn, int row_off, LAS float* scr, int lane) {
    const int nblk = N / 32, kb = item / nblk, nb = item % nblk, k0 = 64 * kb, n0 = 32 * nb;
#pragma unroll 8
    for (int i = 0; i < 32; ++i) { const int kk = 2 * i + (lane >> 5); float w = W[(size_t)(k0 + kk) * N + n0 + (lane & 31)]; if (gain) w *= gain[k0 + kk]; scr[kk * 33 + (lane & 31)] = w; }
    asm volatile("s_waitcnt lgkmcnt(0)" ::: "memory");
    int drow0;
    if (mode == 0) drow0 = row_off + n0; else { const int half = n0 >= Hn ? 1 : 0, c = n0 - half * Hn; drow0 = (c >> 7) * 256 + half * 128 + (c & 127); }
    const int c8 = lane & 7;
#pragma unroll
    for (int j = 0; j < 4; ++j) { const int n = (lane >> 3) + 8 * j; const LAS float* s = scr + (8 * c8) * 33 + n;
        u32x4 o; o.x = cvtpk(s[0 * 33], s[1 * 33]); o.y = cvtpk(s[2 * 33], s[3 * 33]); o.z = cvtpk(s[4 * 33], s[5 * 33]); o.w = cvtpk(s[6 * 33], s[7 * 33]);
        *(u32x4*)(WT + (size_t)(drow0 + n) * K + k0 + 8 * c8) = o; }
    asm volatile("s_waitcnt lgkmcnt(0)" ::: "memory");
}
__device__ __forceinline__ void p0_item64(const float* W, int K, int N, const float* gain, bf16_t* WT, int item, int mode, int Hn, int row_off, LAS float* scr, int lane) {
    const int nkb = K / 64, nb = item / nkb, kb = item - nb * nkb, k0 = 64 * kb, n0 = 64 * nb;
    const int lr = lane >> 4, lc = 4 * (lane & 15);
    f32x4 v[16];
#pragma unroll
    for (int i = 0; i < 16; ++i) v[i] = *(const f32x4*)(W + (size_t)(k0 + 4 * i + lr) * N + n0 + lc);
#pragma unroll
    for (int i = 0; i < 16; ++i) { const int k = 4 * i + lr; f32x4 w = v[i]; if (gain) w = w * gain[k0 + k]; *(LAS f32x4*)(scr + k * 64 + (lc ^ (8 * (k >> 3)))) = w; }
    int drow0;
    if (mode == 0) drow0 = row_off + n0; else { const int half = n0 >= Hn ? 1 : 0, c = n0 - half * Hn; drow0 = (c >> 7) * 256 + half * 128 + (c & 127); }
    const int c8 = lane & 7;
#pragma unroll
    for (int j = 0; j < 8; ++j) { const int n = (lane >> 3) + 8 * j; const LAS float* sp = scr + (8 * c8) * 64 + (n ^ (8 * c8));
        u32x4 o; o.x = cvtpk(sp[0 * 64], sp[1 * 64]); o.y = cvtpk(sp[2 * 64], sp[3 * 64]); o.z = cvtpk(sp[4 * 64], sp[5 * 64]); o.w = cvtpk(sp[6 * 64], sp[7 * 64]);
        *(u32x4*)(WT + (size_t)(drow0 + n) * K + k0 + 8 * c8) = o; }
    asm volatile("s_waitcnt lgkmcnt(0)" ::: "memory");
}
__device__ __forceinline__ void norm_row(const float* xrow, const float* gain, bf16_t* orow, int lane) {
    const f32x4* xr = (const f32x4*)xrow + lane;
    f32x4 v[8]; float s = 0.f;
#pragma unroll
    for (int j = 0; j < 8; ++j) { v[j] = xr[64 * j]; s += (v[j].x * v[j].x + v[j].y * v[j].y) + (v[j].z * v[j].z + v[j].w * v[j].w); }
    const float rstd = 1.0f / sqrtf(wave_sum(s) * (1.f / DM) + EPS);
    u32x2* o8 = (u32x2*)orow + lane;
#pragma unroll
    for (int j = 0; j < 8; ++j) { f32x4 g = {1.f, 1.f, 1.f, 1.f}; if (gain) g = ((const f32x4*)gain)[lane + 64 * j];
        u32x2 w; w.x = cvtpk(v[j].x * rstd * g.x, v[j].y * rstd * g.y); w.y = cvtpk(v[j].z * rstd * g.z, v[j].w * rstd * g.w); o8[64 * j] = w; }
}

__device__ __forceinline__ void sincos_acc(float x, float& sn, float& cs) {
    const double xd = (double)x; const double qd = __builtin_rint(xd * 0.63661977236758134308); const float r = (float)(xd - qd * 1.57079632679489661923);
    const int q = ((int)qd) & 3; const float r2 = r * r;
    const float s = r + r * r2 * (-1.6666667e-1f + r2 * (8.3333333e-3f + r2 * (-1.9841270e-4f + r2 * 2.7557319e-6f)));
    const float c = 1.0f + r2 * (-0.5f + r2 * (4.1666667e-2f + r2 * (-1.3888889e-3f + r2 * (2.4801587e-5f + r2 * -2.7557319e-7f))));
    sn = (q == 0) ? s : (q == 1) ? c : (q == 2) ? -s : -c;
    cs = (q == 0) ? c : (q == 1) ? -s : (q == 2) ? -c : s;
}
__device__ __forceinline__ float gelu_tanh(float y) { const float z = 0.7978845608028654f * (y + 0.044715f * y * y * y); return y * __builtin_amdgcn_rcpf(1.0f + __builtin_amdgcn_exp2f(-2.8853900817779268f * z)); }

template <bool OUT> __device__ __forceinline__ void s5_task(const Args& a, int g, int c, LAS unsigned char* wl, int lane) {
    const int n = lane & 31, hh = lane >> 5;
    const float* a_re = a.in[3]; const float* a_im = a.in[4]; const float* log_dt = a.in[5]; const float* b_re = a.in[6]; const float* b_im = a.in[7];
    const float* c_re = a.in[8]; const float* c_im = a.in[9]; const float* dskip = a.in[10];
    const bf16_t* U = (const bf16_t*)(a.ws + WS_U); bf16_t* G = (bf16_t*)(a.ws + WS_XN); float* SST = (float*)(a.ws + WS_SST);
    float lbr[2], lbi[2]; bf16x8 bfr[4];
    const float dt = expf(log_dt[g]);
#pragma unroll
    for (int s = 0; s < 2; ++s) { const int p = n + 32 * s;
        const float lre = fminf(a_re[g * SP + p], -1e-4f), lim = a_im[g * SP + p];
        const float mag = expf(lre * dt); float sn, cs; sincos_acc(lim * dt, sn, cs);
        lbr[s] = mag * cs; lbi[s] = mag * sn;
        const float den = lre * lre + lim * lim, nr = lbr[s] - 1.0f, ni = lbi[s];
        const float cre = (nr * lre + ni * lim) / den, cim = (ni * lre - nr * lim) / den;
        const f32x4* pbr = (const f32x4*)(b_re + (size_t)(g * SP + p) * SH + 8 * hh); const f32x4* pbi = (const f32x4*)(b_im + (size_t)(g * SP + p) * SH + 8 * hh);
        const f32x4 br0 = pbr[0], br1 = pbr[1], bi0 = pbi[0], bi1 = pbi[1];
        float bre[8], bim[8];
#pragma unroll
        for (int i = 0; i < 4; ++i) { bre[i] = cre * br0[i] - cim * bi0[i]; bim[i] = cre * bi0[i] + cim * br0[i]; bre[4 + i] = cre * br1[i] - cim * bi1[i]; bim[4 + i] = cre * bi1[i] + cim * br1[i]; }
        u32x4 w; w.x = cvtpk(bre[0], bre[1]); w.y = cvtpk(bre[2], bre[3]); w.z = cvtpk(bre[4], bre[5]); w.w = cvtpk(bre[6], bre[7]); bfr[s] = __builtin_bit_cast(bf16x8, w);
        w.x = cvtpk(bim[0], bim[1]); w.y = cvtpk(bim[2], bim[3]); w.z = cvtpk(bim[4], bim[5]); w.w = cvtpk(bim[6], bim[7]); bfr[2 + s] = __builtin_bit_cast(bf16x8, w);
    }
    float hre[2] = {0.f, 0.f}, him[2] = {0.f, 0.f};
    bf16x8 cfr[4]; f32x4 dsk = {0.f, 0.f, 0.f, 0.f};
    if (OUT) {
        const int ho = lane & 15, q4 = lane >> 4;
#pragma unroll
        for (int kk = 0; kk < 4; ++kk) { float v[8];
#pragma unroll
            for (int i = 0; i < 8; ++i) { const int nn = 8 * kk + 2 * q4 + (i >> 2), sel = i & 3; const int p = nn + ((sel & 1) ? 32 : 0);
                v[i] = (sel < 2) ? c_re[(size_t)(g * SH + ho) * SP + p] : -c_im[(size_t)(g * SH + ho) * SP + p]; }
            u32x4 w; w.x = cvtpk(v[0], v[1]); w.y = cvtpk(v[2], v[3]); w.z = cvtpk(v[4], v[5]); w.w = cvtpk(v[6], v[7]); cfr[kk] = __builtin_bit_cast(bf16x8, w); }
        dsk = *(const f32x4*)(dskip + g * SH + 4 * q4);
        float pr[2], pi[2];
#pragma unroll
        for (int s = 0; s < 2; ++s) { pr[s] = lbr[s]; pi[s] = lbi[s];
#pragma unroll
            for (int k = 0; k < 8; ++k) { const float nr2 = pr[s] * pr[s] - pi[s] * pi[s], ni2 = 2.0f * pr[s] * pi[s]; pr[s] = nr2; pi[s] = ni2; } }
        const float* sp = SST + ((size_t)(hh * SG + g) * SP + n) * 2;
#pragma unroll 4
        for (int cc = 0; cc < c; ++cc) { const f32x2_t s0 = *(const f32x2_t*)(sp + (size_t)cc * (2 * SG * SP * 2)); const f32x2_t s1 = *(const f32x2_t*)(sp + (size_t)cc * (2 * SG * SP * 2) + 64);
            float t0 = pr[0] * hre[0] - pi[0] * him[0] + s0.x, t1 = pr[0] * him[0] + pi[0] * hre[0] + s0.y; hre[0] = t0; him[0] = t1;
            t0 = pr[1] * hre[1] - pi[1] * him[1] + s1.x; t1 = pr[1] * him[1] + pi[1] * hre[1] + s1.y; hre[1] = t0; him[1] = t1; }
    }
    const bf16_t* up = U + ((size_t)(((n >> 2) & 1) * SEQ + c * SCH + (n & 3) + 4 * (n >> 3)) * DM + g * SH + 8 * hh);
    bf16x8 afr = *(const bf16x8*)up;
    const f32x16 z16 = {0.f, 0.f, 0.f, 0.f, 0.f, 0.f, 0.f, 0.f, 0.f, 0.f, 0.f, 0.f, 0.f, 0.f, 0.f, 0.f};
    for (int st = 0; st < SCH / 16; ++st) {
        const bf16x8 acur = afr;
        if (st + 1 < SCH / 16) afr = *(const bf16x8*)(up + (size_t)(st + 1) * 16 * DM);
        f32x16 D0 = __builtin_amdgcn_mfma_f32_32x32x16_bf16(acur, bfr[0], z16, 0, 0, 0);
        f32x16 D1 = __builtin_amdgcn_mfma_f32_32x32x16_bf16(acur, bfr[1], z16, 0, 0, 0);
        f32x16 D2 = __builtin_amdgcn_mfma_f32_32x32x16_bf16(acur, bfr[2], z16, 0, 0, 0);
        f32x16 D3 = __builtin_amdgcn_mfma_f32_32x32x16_bf16(acur, bfr[3], z16, 0, 0, 0);
#pragma unroll
        for (int r = 0; r < 16; ++r) {
            float t0 = fmaf(lbr[0], hre[0], fmaf(-lbi[0], him[0], D0[r])), t1 = fmaf(lbr[0], him[0], fmaf(lbi[0], hre[0], D2[r])); hre[0] = t0; him[0] = t1;
            t0 = fmaf(lbr[1], hre[1], fmaf(-lbi[1], him[1], D1[r])); t1 = fmaf(lbr[1], him[1], fmaf(lbi[1], hre[1], D3[r])); hre[1] = t0; him[1] = t1;
            if (OUT) { u32x2 w; w.x = cvtpk(hre[0], hre[1]); w.y = cvtpk(him[0], him[1]); *(LAS u32x2*)(wl + (hh * 16 + r) * 320 + 8 * n) = w; }
        }
        if (OUT) {
            const int tk = lane & 15, q4 = lane >> 4;
#pragma unroll
            for (int tt = 0; tt < 2; ++tt) {
                f32x4 y = {0.f, 0.f, 0.f, 0.f};
#pragma unroll
                for (int kk = 0; kk < 4; ++kk) { const bf16x8 hb = *(const LAS bf16x8*)(wl + (tt * 16 + tk) * 320 + (32 * kk + 8 * q4) * 2); y = __builtin_amdgcn_mfma_f32_16x16x32_bf16(cfr[kk], hb, y, 0, 0, 0); }
                const size_t idx = (size_t)(tt * SEQ + c * SCH + st * 16 + tk) * DM + g * SH + 4 * q4;
                const u32x2 uu = *(const u32x2*)(U + idx);
                const float y0 = y[0] + dsk[0] * bf_lo(uu.x), y1 = y[1] + dsk[1] * bf_hi(uu.x), y2 = y[2] + dsk[2] * bf_lo(uu.y), y3 = y[3] + dsk[3] * bf_hi(uu.y);
                u32x2 w; w.x = cvtpk(gelu_tanh(y0), gelu_tanh(y1)); w.y = cvtpk(gelu_tanh(y2), gelu_tanh(y3)); *(u32x2*)(G + idx) = w;
            }
        }
    }
    if (!OUT) {
        float* sp = SST + ((size_t)((c * 2 + hh) * SG + g) * SP + n) * 2;
        *(f32x2_t*)sp = (f32x2_t){hre[0], him[0]}; *(f32x2_t*)(sp + 64) = (f32x2_t){hre[1], him[1]};
    }
}

__device__ __forceinline__ unsigned off_b(unsigned row, unsigned ch) { return 256u * row + 16u * (ch ^ (((row & 3) << 2) | ((row >> 2) & 3))); }
typedef short v4i16_t __attribute__((ext_vector_type(4)));
__device__ __forceinline__ s16x4 vtr(const LAS unsigned char* p) { return __builtin_bit_cast(s16x4, __builtin_amdgcn_ds_read_tr16_b64_v4i16((LAS v4i16_t*)p)); }

__device__ __forceinline__ void att_glds16(const void* gsrc, unsigned lds_dst) { unsigned keep;
    asm volatile("s_mov_b32 %0, m0\n\ts_mov_b32 m0, %2\n\ts_nop 0\n\tglobal_load_lds_dwordx4 %1, off\n\ts_mov_b32 m0, %0" : "=&s"(keep) : "v"(gsrc), "s"(lds_dst) : "memory"); }
template <int GRP> __device__ __forceinline__ void attn_q_load(const Args& a, int b, int head, int Ts, int uidx, int lane, u32x4 (&raw)[8]) {
    constexpr int dil = (GRP == 0) ? 1 : (GRP == 1) ? 4 : 16;
    const bf16_t* Qg = (const bf16_t*)(a.ws + (GRP == 0 ? WS_Q0 : GRP == 1 ? WS_Q1 : WS_Q2));
    constexpr int nblk = 64 / dil;
    const int n = lane & 31, h = lane >> 5, r = uidx / nblk, blk = uidx % nblk, tq = Ts + r + dil * (32 * blk + n);
    const bf16_t* qrow = Qg + ((size_t)((b * 16 + head) * SEQ + tq) * HP);
#pragma unroll
    for (int kk = 0; kk < 8; ++kk) raw[kk] = *(const u32x4*)(qrow + 16 * kk + 8 * h);
}
template <int GRP> __device__ __forceinline__ void attn_unit(const Args& a, int b, int head, int Ts, int uidx, int unext, LAS unsigned char* vl, int lane, u32x4 (&raw)[8]) {
    constexpr int dil = (GRP == 0) ? 1 : (GRP == 1) ? 4 : 16;
    constexpr float THR = 40.0f;
    const int n = lane & 31, h = lane >> 5;
    bf16_t* Qg = (bf16_t*)(a.ws + (GRP == 0 ? WS_Q0 : GRP == 1 ? WS_Q1 : WS_Q2));
    const bf16_t* Kb = (const bf16_t*)(a.ws + WS_K); const bf16_t* Vb = (const bf16_t*)(a.ws + WS_V);
    float* LSE = (float*)(a.ws + WS_LSE);
    const float* qn = a.in[16] + GRP * HD;
    constexpr int nblk = 64 / dil;
    const int r = uidx / nblk, blk = uidx % nblk;
    const int tq = Ts + r + dil * (32 * blk + n);
    bf16_t* qrow = Qg + ((size_t)((b * 16 + head) * SEQ + tq) * HP);
    int kt = (5 - blk % 5) % 5;
    const int vrow_l = lane >> 4; const int vch[4] = {(lane & 15) ^ ((vrow_l << 2) | 0), (lane & 15) ^ ((vrow_l << 2) | 1), (lane & 15) ^ ((vrow_l << 2) | 2), (lane & 15) ^ ((vrow_l << 2) | 3)};
    const bf16_t* vbase = Vb + ((size_t)(b * 16 + head) * SEQ * HP);
    const unsigned vlds0 = (unsigned)(uintptr_t)vl;
    const bf16_t* kbase = Kb + ((size_t)(b * 16 + head) * SEQ * HP);
#define ATT_DMA_T(base_, kt_, buf_) do { const int jb_ = 32 * blk - 128 + 32 * (kt_); _Pragma("unroll") for (int i_ = 0; i_ < 8; ++i_) { int tk_ = Ts + r + dil * (jb_ + 4 * i_ + vrow_l); tk_ = tk_ < 0 ? 0 : tk_; \
        att_glds16((base_) + (size_t)tk_ * HP + 8 * vch[i_ & 3], (unsigned)__builtin_amdgcn_readfirstlane((int)(vlds0 + (buf_) * 8192 + i_ * 1024))); } } while (0)
    asm volatile("" ::: "memory");
    ATT_DMA_T(kbase, kt, 0);
    ATT_DMA_T(vbase, kt, 1);
    asm volatile("" ::: "memory");
    const unsigned kx = ((n & 3) << 2) | ((n >> 2) & 3);
    bf16x8 qf[8];
    {
        float ss = 0.f;
#pragma unroll
        for (int kk = 0; kk < 8; ++kk)
#pragma unroll
            for (int e = 0; e < 4; ++e) { const float lo = bf_lo(raw[kk][e]), hi = bf_hi(raw[kk][e]); ss += lo * lo + hi * hi; }
        ss += __shfl_xor(ss, 32);
        const float sc = (1.0f / sqrtf(ss * (1.f / HD) + EPS)) * 0.08838834764831845f * 1.4426950408889634f;
#pragma unroll
        for (int kk = 0; kk < 8; ++kk) { const f32x4 g0 = *(const f32x4*)(qn + 16 * kk + 8 * h), g1 = *(const f32x4*)(qn + 16 * kk + 8 * h + 4); u32x4 w;
            w.x = cvtpk(bf_lo(raw[kk].x) * sc * g0.x, bf_hi(raw[kk].x) * sc * g0.y); w.y = cvtpk(bf_lo(raw[kk].y) * sc * g0.z, bf_hi(raw[kk].y) * sc * g0.w);
            w.z = cvtpk(bf_lo(raw[kk].z) * sc * g1.x, bf_hi(raw[kk].z) * sc * g1.y); w.w = cvtpk(bf_lo(raw[kk].w) * sc * g1.z, bf_hi(raw[kk].w) * sc * g1.w);
            qf[kk] = __builtin_bit_cast(bf16x8, w); }
    }
    const float slope2 = exp2f(-8.0f * (float)(3 * head + GRP + 1) / 48.0f) * (float)dil * 1.4426950408889634f;
    float m = 0.f, l = 0.f;
    const f32x16 z16 = {0.f, 0.f, 0.f, 0.f, 0.f, 0.f, 0.f, 0.f, 0.f, 0.f, 0.f, 0.f, 0.f, 0.f, 0.f, 0.f};
    f32x16 O[4] = {z16, z16, z16, z16};
    unsigned tro[2][2], cbo[4];
    { const unsigned blk2 = (lane >> 4) & 1, q = (lane & 15) >> 2, p = lane & 3;
#pragma unroll
      for (int s = 0; s < 2; ++s)
#pragma unroll
        for (int t = 0; t < 2; ++t) { const unsigned row = 16 * s + 4 * h + 8 * t + q; tro[s][t] = 256u * row + 16u * ((2 * blk2 + (p >> 1)) ^ ((row >> 2) & 3)) + 8 * (p & 1); }
#pragma unroll
      for (int cb = 0; cb < 4; ++cb) cbo[cb] = 64u * ((unsigned)cb ^ q); }
#pragma unroll 1
    for (int st = 0; st < 5; ++st) {
        const bool has_next = st < 4; const int ktn = (kt == 4) ? 0 : kt + 1;
        const int jbase = 32 * blk - 128 + 32 * kt;
        const float lb = -slope2 * (float)(128 - 32 * kt + n - 4 * h) - m;
        f32x16 S;
#pragma unroll
        for (int rr = 0; rr < 16; ++rr) S[rr] = fmaf(slope2, (float)((rr & 3) + 8 * (rr >> 2)), lb);
        asm volatile("s_waitcnt vmcnt(8)" ::: "memory");
        bf16x8 kf[8];
#pragma unroll
        for (int kk = 0; kk < 8; ++kk) kf[kk] = *(const LAS bf16x8*)(vl + 256 * n + 16 * ((unsigned)(2 * kk + h) ^ kx));
#pragma unroll
        for (int kk = 0; kk < 8; ++kk) S = __builtin_amdgcn_mfma_f32_32x32x16_bf16(kf[kk], qf[kk], S, 0, 0, 0);
        asm volatile("s_waitcnt lgkmcnt(0)" ::: "memory");
        if (has_next) ATT_DMA_T(kbase, ktn, 0);
        asm volatile("" ::: "memory");
        if (kt == 0 || kt == 4 || Ts + r + dil * jbase < 0) {
#pragma unroll
            for (int rr = 0; rr < 16; ++rr) { const int j = crow(rr, h); const int dist = 128 - 32 * kt + n - j; const bool ok = (dist >= 0) && (dist <= 128) && (Ts + r + dil * (jbase + j) >= 0);
                S[rr] = ok ? S[rr] : -INFINITY; }
        }
        float tmax = fmaxf(fmaxf(S[0], S[1]), fmaxf(S[2], S[3]));
#pragma unroll
        for (int rr = 4; rr < 16; rr += 4) tmax = fmaxf(tmax, fmaxf(fmaxf(S[rr], S[rr + 1]), fmaxf(S[rr + 2], S[rr + 3])));
        tmax = fmaxf(tmax, __shfl_xor(tmax, 32));
        if (__builtin_expect(__any(tmax > THR), 0)) {
            const float dl = tmax > THR ? tmax : 0.f; const float f = __builtin_amdgcn_exp2f(-dl); m += dl; l *= f;
#pragma unroll
            for (int rr = 0; rr < 16; ++rr) S[rr] -= dl;
#pragma unroll
            for (int cb = 0; cb < 4; ++cb)
#pragma unroll
                for (int rr = 0; rr < 16; ++rr) O[cb][rr] *= f;
        }
        float ps = 0.f;
#pragma unroll
        for (int rr = 0; rr < 16; ++rr) { const float p = __builtin_amdgcn_exp2f(S[rr]); S[rr] = p; ps += p; }
        l += ps;
        bf16x8 pf[2];
#pragma unroll
        for (int s = 0; s < 2; ++s) { u32x4 w; w.x = cvtpk(S[8 * s + 0], S[8 * s + 1]); w.y = cvtpk(S[8 * s + 2], S[8 * s + 3]); w.z = cvtpk(S[8 * s + 4], S[8 * s + 5]); w.w = cvtpk(S[8 * s + 6], S[8 * s + 7]); pf[s] = __builtin_bit_cast(bf16x8, w); }
        if (has_next) asm volatile("s_waitcnt vmcnt(8)" ::: "memory"); else asm volatile("s_waitcnt vmcnt(0)" ::: "memory");
        const LAS unsigned char* vb = vl + 8192;
#pragma unroll
        for (int cb = 0; cb < 4; ++cb)
#pragma unroll
            for (int s = 0; s < 2; ++s) { const s16x4 lo = vtr(vb + tro[s][0] + cbo[cb]), hi = vtr(vb + tro[s][1] + cbo[cb]);
                const bf16x8 vf = {lo[0], lo[1], lo[2], lo[3], hi[0], hi[1], hi[2], hi[3]};
                O[cb] = __builtin_amdgcn_mfma_f32_32x32x16_bf16(vf, pf[s], O[cb], 0, 0, 0); }
        asm volatile("s_waitcnt lgkmcnt(0)" ::: "memory");
        if (has_next) ATT_DMA_T(vbase, ktn, 1);
        asm volatile("" ::: "memory");
        __builtin_amdgcn_s_barrier();
        kt = ktn;
    }
#undef ATT_DMA_T
    const float lt = l + __shfl_xor(l, 32);
    const float lse2 = m + __builtin_amdgcn_logf(lt);
    float w0 = 1.0f / lt, w1 = 0.f, w2 = 0.f;
    const size_t hrow = (size_t)(b * 16 + head) * SEQ + tq;
    if (GRP != 0) { if (h == 0) LSE[(size_t)(GRP - 1) * MTOK * NHEAD + hrow] = lse2; }
    else { const float l1 = LSE[hrow], l2 = LSE[(size_t)MTOK * NHEAD + hrow];
        const float mx = fmaxf(lse2, fmaxf(l1, l2)); const float e0 = __builtin_amdgcn_exp2f(lse2 - mx), e1 = __builtin_amdgcn_exp2f(l1 - mx), e2 = __builtin_amdgcn_exp2f(l2 - mx);
        const float inv = 1.0f / (e0 + e1 + e2); w0 = e0 * inv / lt; w1 = e1 * inv; w2 = e2 * inv; }
    const bf16_t* o1row = (const bf16_t*)(a.ws + WS_Q1) + hrow * HP; const bf16_t* o2row = (const bf16_t*)(a.ws + WS_Q2) + hrow * HP;
    bf16_t* orow = (GRP == 0) ? (bf16_t*)a.out + ((size_t)(b * SEQ + tq) * DM + head * HD) : qrow;
#pragma unroll
    for (int cb = 0; cb < 4; ++cb)
#pragma unroll
        for (int rg = 0; rg < 4; ++rg) { const int d0 = 32 * cb + 8 * rg + 4 * h;
            float o0 = O[cb][4 * rg + 0] * w0, o1 = O[cb][4 * rg + 1] * w0, o2 = O[cb][4 * rg + 2] * w0, o3 = O[cb][4 * rg + 3] * w0;
            if (GRP == 0) { const u32x2 x1 = *(const u32x2*)(o1row + d0), x2 = *(const u32x2*)(o2row + d0);
                o0 += w1 * bf_lo(x1.x) + w2 * bf_lo(x2.x); o1 += w1 * bf_hi(x1.x) + w2 * bf_hi(x2.x); o2 += w1 * bf_lo(x1.y) + w2 * bf_lo(x2.y); o3 += w1 * bf_hi(x1.y) + w2 * bf_hi(x2.y); }
            u32x2 w; w.x = cvtpk(o0, o1); w.y = cvtpk(o2, o3); *(u32x2*)(orow + d0) = w; }
}
template <int GRP> __device__ __forceinline__ void attn_stage(const Args& a, int b, int head, int Ts, int wave, LAS unsigned char* vl, int lane) {
    asm volatile("" : "+v"(lane));
    u32x4 raw[8];
    for (int u = wave; u < 64; u += NWAVES) { attn_q_load<GRP>(a, b, head, Ts, u, lane, raw); attn_unit<GRP>(a, b, head, Ts, u, (u + NWAVES < 64) ? u + NWAVES : -1, vl, lane, raw); }
}


struct AttStep { int dil, grp, rd, s, B0, nbr; };
__device__ __forceinline__ AttStep att_decode(int S) { AttStep t; const int st = S / 40; t.rd = (S % 40) / 5; t.s = S % 5; t.dil = st == 0 ? 16 : st == 1 ? 4 : 1; t.grp = 2 - st;
    t.B0 = (t.dil == 16) ? 0 : (t.dil == 4 ? (t.rd & 1) * 8 : t.rd * 8); t.nbr = (t.dil == 16) ? 4 : 8; return t; }
__device__ __forceinline__ int att_res(const AttStep& t, int group) { return (t.dil == 16) ? 2 * t.rd + group : (t.dil == 4 ? (t.rd >> 1) : 0); }
__device__ __forceinline__ int att_tmin(const AttStep& t) { return t.B0 + ((t.s - t.B0 % 5 + 5) % 5); }
__device__ __forceinline__ void attn_shared(const Args& a, int b, int head, int Ts, int wave, LAS unsigned char* lds, int lane) {
    asm volatile("" : "+v"(lane));
    int hp = HP; asm volatile("" : "+s"(hp));
    LAS float* gl = (LAS float*)(lds + 131072 + 1024);
    { const int tix = wave * 64 + lane; if (tix < 3 * HD) gl[tix] = a.in[16][tix]; }
    asm volatile("" ::: "memory");
    constexpr float THR = 40.0f;
    const int n = lane & 31, h = lane >> 5;
    const bf16_t* kbase = (const bf16_t*)(a.ws + WS_K) + ((size_t)(b * 16 + head) * SEQ * hp);
    const bf16_t* vbase = (const bf16_t*)(a.ws + WS_V) + ((size_t)(b * 16 + head) * SEQ * hp);
    float* LSE = (float*)(a.ws + WS_LSE);
    const unsigned lds0 = (unsigned)(uintptr_t)lds;
    const int vrow_l = lane >> 4;
    const unsigned kx = ((n & 3) << 2) | ((n >> 2) & 3);
    unsigned tro[2][2], q64;
    { const unsigned blk2 = (lane >> 4) & 1, q = (lane & 15) >> 2, p = lane & 3;
#pragma unroll
      for (int s = 0; s < 2; ++s)
#pragma unroll
        for (int t = 0; t < 2; ++t) { const unsigned row = 16 * s + 4 * h + 8 * t + q; tro[s][t] = 256u * row + 16u * ((2 * blk2 + (p >> 1)) ^ ((row >> 2) & 3)) + 8 * (p & 1); }
      q64 = 64u * q; }
#define ATT_ISSUE(Sx_) do { const AttStep t_ = att_decode(Sx_); const int tmin_ = att_tmin(t_); \
        _Pragma("unroll") for (int slot_ = 0; slot_ < 4; ++slot_) { const int gi_ = (t_.dil == 16) ? (slot_ >> 1) : 0, idx_ = (t_.dil == 16) ? (slot_ & 1) : slot_; const int T_ = tmin_ + 5 * idx_; \
            if (T_ <= t_.B0 + t_.nbr + 3 && (t_.dil == 16 || slot_ < 3)) { int tk_ = Ts + att_res(t_, gi_) + t_.dil * (32 * (T_ - 4) + 4 * wave + vrow_l); tk_ = tk_ < 0 ? 0 : tk_; \
                const size_t go_ = (size_t)tk_ * hp + 8 * ((lane & 15) ^ ((vrow_l << 2) | (wave & 3))); const unsigned ld_ = lds0 + (((Sx_) & 1) * 65536 + slot_ * 16384 + wave * 1024); \
                att_glds16(kbase + go_, (unsigned)__builtin_amdgcn_readfirstlane((int)ld_)); att_glds16(vbase + go_, (unsigned)__builtin_amdgcn_readfirstlane((int)(ld_ + 8192))); } } } while (0)
#define ATT_QROW(t_, grp_) ((bf16_t*)(a.ws + ((grp_) == 0 ? WS_Q0 : (grp_) == 1 ? WS_Q1 : WS_Q2)) + ((size_t)((b * 16 + head) * SEQ + Ts + att_res(t_, (t_.dil == 16) ? (wave >> 2) : 0) + t_.dil * (32 * (t_.B0 + ((t_.dil == 16) ? (wave & 3) : wave)) + n)) * hp))
    u32x4 raw[8];
    { const AttStep t0 = att_decode(0); const bf16_t* qr = ATT_QROW(t0, t0.grp);
#pragma unroll
      for (int kk = 0; kk < 8; ++kk) raw[kk] = *(const u32x4*)(qr + 16 * kk + 8 * h); }
    asm volatile("" ::: "memory");
    ATT_ISSUE(0);
    asm volatile("s_waitcnt vmcnt(0) lgkmcnt(0)" ::: "memory"); __builtin_amdgcn_s_barrier(); asm volatile("" ::: "memory");
    bf16x8 qf[8]; float slope2 = 0.f, m = 0.f, l = 0.f;
    const f32x16 z16 = {0.f, 0.f, 0.f, 0.f, 0.f, 0.f, 0.f, 0.f, 0.f, 0.f, 0.f, 0.f, 0.f, 0.f, 0.f, 0.f};
    f32x16 O[4] = {z16, z16, z16, z16};
#pragma unroll 1
    for (int S = 0; S < 120; ++S) {
        const AttStep t = att_decode(S);
        asm volatile("" ::: "memory");
        if (S + 1 < 120) ATT_ISSUE(S + 1);
        asm volatile("" ::: "memory");
        const int group = (t.dil == 16) ? (wave >> 2) : 0, B = t.B0 + ((t.dil == 16) ? (wave & 3) : wave), r = att_res(t, group);
        if (t.s == 4 && S + 1 < 120) {
            const AttStep tn = att_decode(S + 1); const bf16_t* qr = ATT_QROW(tn, tn.grp);
#pragma unroll
            for (int kk = 0; kk < 8; ++kk) raw[kk] = *(const u32x4*)(qr + 16 * kk + 8 * h); }
        if (t.s == 0) {
            const LAS float* qn = gl + t.grp * HD; float ss = 0.f;
#pragma unroll
            for (int kk = 0; kk < 8; ++kk)
#pragma unroll
                for (int e = 0; e < 4; ++e) { const float lo = bf_lo(raw[kk][e]), hi = bf_hi(raw[kk][e]); ss += lo * lo + hi * hi; }
            ss += __shfl_xor(ss, 32);
            const float sc = (1.0f / sqrtf(ss * (1.f / HD) + EPS)) * 0.08838834764831845f * 1.4426950408889634f;
#pragma unroll
            for (int kk = 0; kk < 8; ++kk) { const f32x4 g0 = *(const LAS f32x4*)(qn + 16 * kk + 8 * h), g1 = *(const LAS f32x4*)(qn + 16 * kk + 8 * h + 4); u32x4 w;
                w.x = cvtpk(bf_lo(raw[kk].x) * sc * g0.x, bf_hi(raw[kk].x) * sc * g0.y); w.y = cvtpk(bf_lo(raw[kk].y) * sc * g0.z, bf_hi(raw[kk].y) * sc * g0.w);
                w.z = cvtpk(bf_lo(raw[kk].z) * sc * g1.x, bf_hi(raw[kk].z) * sc * g1.y); w.w = cvtpk(bf_lo(raw[kk].w) * sc * g1.z, bf_hi(raw[kk].w) * sc * g1.w);
                qf[kk] = __builtin_bit_cast(bf16x8, w); }
            slope2 = exp2f(-8.0f * (float)(3 * head + t.grp + 1) / 48.0f) * (float)t.dil * 1.4426950408889634f;
            m = 0.f; l = 0.f;
#pragma unroll
            for (int cb = 0; cb < 4; ++cb) O[cb] = z16;
        }
        const int kt = (t.s - B % 5 + 5) % 5, T = B + kt, slot = ((t.dil == 16) ? 2 * group : 0) + (T - att_tmin(t)) / 5;
        const LAS unsigned char* kl = lds + ((S & 1) * 65536 + slot * 16384);
        const int jbase = 32 * (T - 4);
        const float lb = -slope2 * (float)(128 - 32 * kt + n - 4 * h) - m;
        f32x16 Sc;
#pragma unroll
        for (int rr = 0; rr < 16; ++rr) Sc[rr] = fmaf(slope2, (float)((rr & 3) + 8 * (rr >> 2)), lb);
        { bf16x8 kf[8];
#pragma unroll
          for (int kk = 0; kk < 8; ++kk) kf[kk] = *(const LAS bf16x8*)(kl + 256 * n + 16 * ((unsigned)(2 * kk + h) ^ kx));
#pragma unroll
          for (int kk = 0; kk < 8; ++kk) Sc = __builtin_amdgcn_mfma_f32_32x32x16_bf16(kf[kk], qf[kk], Sc, 0, 0, 0); }
        if (Ts + r + t.dil * jbase < 0) {
#pragma unroll
            for (int rr = 0; rr < 16; ++rr) { const int j = crow(rr, h); const int dist = 128 - 32 * kt + n - j; const bool ok = (dist >= 0) && (dist <= 128) && (Ts + r + t.dil * (jbase + j) >= 0);
                Sc[rr] = ok ? Sc[rr] : -INFINITY; }
        } else if (kt == 0) {
#pragma unroll
            for (int rr = 0; rr < 16; ++rr) Sc[rr] = (crow(rr, h) >= n) ? Sc[rr] : -INFINITY;
        } else if (kt == 4) {
#pragma unroll
            for (int rr = 0; rr < 16; ++rr) Sc[rr] = (crow(rr, h) <= n) ? Sc[rr] : -INFINITY;
        }
        float tmax = fmaxf(fmaxf(Sc[0], Sc[1]), fmaxf(Sc[2], Sc[3]));
#pragma unroll
        for (int rr = 4; rr < 16; rr += 4) tmax = fmaxf(tmax, fmaxf(fmaxf(Sc[rr], Sc[rr + 1]), fmaxf(Sc[rr + 2], Sc[rr + 3])));
        if (__builtin_expect(__any(tmax > THR), 0)) {
            tmax = fmaxf(tmax, __shfl_xor(tmax, 32));
            const float dl = tmax > THR ? tmax : 0.f; const float f = __builtin_amdgcn_exp2f(-dl); m += dl; l *= f;
#pragma unroll
            for (int rr = 0; rr < 16; ++rr) Sc[rr] -= dl;
#pragma unroll
            for (int cb = 0; cb < 4; ++cb)
#pragma unroll
                for (int rr = 0; rr < 16; ++rr) O[cb][rr] *= f;
        }
        float ps = 0.f;
#pragma unroll
        for (int rr = 0; rr < 16; ++rr) { const float p = __builtin_amdgcn_exp2f(Sc[rr]); Sc[rr] = p; ps += p; }
        l += ps;
        bf16x8 pf[2];
#pragma unroll
        for (int s2 = 0; s2 < 2; ++s2) { u32x4 w; w.x = cvtpk(Sc[8 * s2 + 0], Sc[8 * s2 + 1]); w.y = cvtpk(Sc[8 * s2 + 2], Sc[8 * s2 + 3]); w.z = cvtpk(Sc[8 * s2 + 4], Sc[8 * s2 + 5]); w.w = cvtpk(Sc[8 * s2 + 6], Sc[8 * s2 + 7]); pf[s2] = __builtin_bit_cast(bf16x8, w); }
        { const LAS unsigned char* vb = kl + 8192;
#pragma unroll
          for (int cb = 0; cb < 4; ++cb)
#pragma unroll
            for (int s2 = 0; s2 < 2; ++s2) { const unsigned co = (64u * cb) ^ q64; const s16x4 lo = vtr(vb + tro[s2][0] + co), hi = vtr(vb + tro[s2][1] + co);
                const bf16x8 vf = {lo[0], lo[1], lo[2], lo[3], hi[0], hi[1], hi[2], hi[3]};
                O[cb] = __builtin_amdgcn_mfma_f32_32x32x16_bf16(vf, pf[s2], O[cb], 0, 0, 0); } }
        if (t.s == 4) {
            const int tq = Ts + r + t.dil * (32 * B + n);
            const float lt = l + __shfl_xor(l, 32);
            const float lse2 = m + __builtin_amdgcn_logf(lt);
            float w0 = 1.0f / lt, w1 = 0.f, w2 = 0.f;
            const size_t hrow = (size_t)(b * 16 + head) * SEQ + tq;
            if (t.grp != 0) { if (h == 0) LSE[(size_t)(t.grp - 1) * MTOK * NHEAD + hrow] = lse2; }
            else { const float l1 = LSE[hrow], l2 = LSE[(size_t)MTOK * NHEAD + hrow];
                const float mx = fmaxf(lse2, fmaxf(l1, l2)); const float e0 = __builtin_amdgcn_exp2f(lse2 - mx), e1 = __builtin_amdgcn_exp2f(l1 - mx), e2 = __builtin_amdgcn_exp2f(l2 - mx);
                const float inv = 1.0f / (e0 + e1 + e2); w0 = e0 * inv / lt; w1 = e1 * inv; w2 = e2 * inv; }
            LAS unsigned char* stg = lds + LDS_STG + wave * STG_WAVE; LAS float* wq = (LAS float*)(stg + 32 * STG_PITCH);
            if (t.grp == 0 && h == 0) { wq[2 * n] = w1; wq[2 * n + 1] = w2; }
            const bf16_t* o1b = (const bf16_t*)(a.ws + WS_Q1); const bf16_t* o2b = (const bf16_t*)(a.ws + WS_Q2);
            bf16_t* ogb = (bf16_t*)(a.ws + (t.grp == 1 ? WS_Q1 : WS_Q2));
#pragma unroll
            for (int cb = 0; cb < 4; ++cb) {
#pragma unroll
                for (int rg = 0; rg < 4; ++rg) { u32x2 w; w.x = cvtpk(O[cb][4 * rg + 0] * w0, O[cb][4 * rg + 1] * w0); w.y = cvtpk(O[cb][4 * rg + 2] * w0, O[cb][4 * rg + 3] * w0);
                    *(LAS u32x2*)(stg + n * STG_PITCH + 16 * rg + 8 * h) = w; }
#pragma unroll
                for (int j = 0; j < 2; ++j) { const int c = lane + 64 * j, row = c >> 2, part = c & 3;
                    const u32x4 v = *(const LAS u32x4*)(stg + row * STG_PITCH + part * 16);
                    const int tqr = Ts + r + t.dil * (32 * B + row); const size_t hr = (size_t)(b * 16 + head) * SEQ + tqr; const int dcol = 32 * cb + 8 * part;
                    if (t.grp == 0) { const u32x4 x1 = *(const u32x4*)(o1b + hr * hp + dcol), x2 = *(const u32x4*)(o2b + hr * hp + dcol); const float a1 = wq[2 * row], a2 = wq[2 * row + 1]; u32x4 o;
                        o.x = cvtpk(bf_lo(v.x) + a1 * bf_lo(x1.x) + a2 * bf_lo(x2.x), bf_hi(v.x) + a1 * bf_hi(x1.x) + a2 * bf_hi(x2.x));
                        o.y = cvtpk(bf_lo(v.y) + a1 * bf_lo(x1.y) + a2 * bf_lo(x2.y), bf_hi(v.y) + a1 * bf_hi(x1.y) + a2 * bf_hi(x2.y));
                        o.z = cvtpk(bf_lo(v.z) + a1 * bf_lo(x1.z) + a2 * bf_lo(x2.z), bf_hi(v.z) + a1 * bf_hi(x1.z) + a2 * bf_hi(x2.z));
                        o.w = cvtpk(bf_lo(v.w) + a1 * bf_lo(x1.w) + a2 * bf_lo(x2.w), bf_hi(v.w) + a1 * bf_hi(x1.w) + a2 * bf_hi(x2.w));
                        *(u32x4*)((bf16_t*)a.out + ((size_t)(b * SEQ + tqr) * DM + head * HD + dcol)) = o; }
                    else *(u32x4*)(ogb + hr * hp + dcol) = v;
                    asm volatile("" ::: "memory"); }
                asm volatile("" ::: "memory");
            }
        }
        if (S == 79) __threadfence();
        if (t.s == 4 && S != 79) asm volatile("s_waitcnt vmcnt(8) lgkmcnt(0)" ::: "memory");
        else asm volatile("s_waitcnt vmcnt(0) lgkmcnt(0)" ::: "memory");
        __builtin_amdgcn_s_barrier(); asm volatile("" ::: "memory");
        if (S == 79) __builtin_amdgcn_fence(__ATOMIC_ACQUIRE, "agent");
    }
#undef ATT_ISSUE
#undef ATT_QROW
}

#define XB_TMO      128
#define XB_XCNT(j)  (256  + 64 * (j))
#define XB_XSUB(j)  (1280 + 64 * (j))
#define XB_XGEN(j)  (2304 + 64 * (j))
#define XB_TOP      3328
#define XB_TOPGEN   3392
#define XCD_BAR_WORDS 3456
#define XB_SPIN_CAP (1u << 18)

__device__ __forceinline__ unsigned xb_ld(unsigned* p)              { return __hip_atomic_load(p, __ATOMIC_RELAXED, __HIP_MEMORY_SCOPE_AGENT); }
__device__ __forceinline__ unsigned xb_add(unsigned* p, unsigned v) { return __hip_atomic_fetch_add(p, v, __ATOMIC_RELAXED, __HIP_MEMORY_SCOPE_AGENT); }
__device__ __forceinline__ unsigned xb_xcc_id() { return (unsigned)__builtin_amdgcn_s_getreg((3 << 11) | 20) & 0xFu; }
#define XB_SPIN(cond, bar) do { unsigned _sp = 0; while (cond) { __builtin_amdgcn_s_sleep(1); \
    if ((++_sp & 255u) == 0u) { if (xb_ld(&(bar)[XB_TMO])) break; if (_sp > XB_SPIN_CAP) { atomicAdd(&(bar)[XB_TMO], 1u); break; } } } } while (0)

struct XcdBarrier {
    unsigned* bar; unsigned x;
    volatile LAS unsigned* st;
};

__device__ __forceinline__ XcdBarrier xcd_barrier_post(unsigned* bar, volatile LAS unsigned* st) {
    XcdBarrier b; b.bar = bar; b.x = xb_xcc_id(); b.st = st;
    if (threadIdx.x == 0) (void)xb_add(&bar[XB_XCNT(b.x)], 1u);
    return b;
}
__device__ __forceinline__ void xcd_barrier_complete(unsigned* bar, unsigned x, unsigned& nloc, unsigned& nx) {
    const unsigned G = gridDim.x * gridDim.y * gridDim.z;
    unsigned sum, cnt, mine, sp = 0u;
    for (;;) {
        sum = 0u; cnt = 0u; mine = 0u;
#pragma unroll
        for (unsigned j = 0; j < 16; ++j) { const unsigned c = xb_ld(&bar[XB_XCNT(j)]); sum += c; cnt += (c > 0u) ? 1u : 0u; mine = (j == x) ? c : mine; }
        if (sum == G) break;
        __builtin_amdgcn_s_sleep(1);
        if ((++sp & 255u) == 0u) { if (xb_ld(&bar[XB_TMO])) break; if (sp > XB_SPIN_CAP) { atomicAdd(&bar[XB_TMO], 1u); break; } }
    }
    nloc = mine > 0u ? mine : 1u; nx = cnt > 0u ? cnt : 1u;
}

__device__ __forceinline__ void xcd_barrier(const XcdBarrier& b) {
    asm volatile("s_waitcnt vmcnt(0)" ::: "memory");
    __syncthreads();
    if (threadIdx.x == 0) {
        unsigned* bar = b.bar;
        __builtin_amdgcn_s_waitcnt(0);
        unsigned nloc = b.st[0], nx = b.st[1];
        if (nloc == 0u) { xcd_barrier_complete(bar, b.x, nloc, nx); b.st[0] = nloc; b.st[1] = nx; }
        const unsigned old = xb_add(&bar[XB_XSUB(b.x)], 1u);
        const unsigned gen = old / nloc;
        if (old + 1u == (gen + 1u) * nloc) {
            __builtin_amdgcn_fence(__ATOMIC_RELEASE, "agent");
            asm volatile("s_waitcnt vmcnt(0)" ::: "memory");
            const unsigned og = xb_add(&bar[XB_TOP], 1u);
            const unsigned tg = og / nx;
            if (og + 1u == (tg + 1u) * nx) xb_add(&bar[XB_TOPGEN], 1u);
            else XB_SPIN(xb_ld(&bar[XB_TOPGEN]) == tg, bar);
            __builtin_amdgcn_fence(__ATOMIC_ACQUIRE, "agent");
            xb_add(&bar[XB_XGEN(b.x)], 1u);
            asm volatile("s_waitcnt vmcnt(0)" ::: "memory");
        } else {
            XB_SPIN(xb_ld(&bar[XB_XGEN(b.x)]) == gen, bar);
            __builtin_amdgcn_fence(__ATOMIC_ACQUIRE, "agent");
            asm volatile("s_waitcnt vmcnt(0)" ::: "memory");
        }
    }
    __syncthreads();
}

__global__ void __launch_bounds__(NWAVES * 64, 2) mega_fwd(Args a) {
    extern __shared__ __attribute__((aligned(16))) unsigned char lds_raw[];
    LAS unsigned char* lds = (LAS unsigned char*)lds_raw;
    cg::grid_group grid = cg::this_grid();
    const int tid = threadIdx.x, lane = tid & 63, wave = __builtin_amdgcn_readfirstlane(tid >> 6);
    const int G = gridDim.x, bx = blockIdx.x;
    const int vcu = (G % 8 == 0) ? (bx % 8) * (G / 8) + bx / 8 : bx;
    const int gw = vcu * NWAVES + wave, NGW = G * NWAVES;
    unsigned char* ws = a.ws;
    const float* x_in = a.in[0]; float* xo = a.out;
    volatile LAS unsigned* MISC = (volatile LAS unsigned*)(lds + 131072 + 320);
    if (tid < 32) MISC[tid] = 0u;
    __syncthreads();
    bf16_t* Wglu = (bf16_t*)(ws + WS_WGLU); bf16_t* Wqkv = (bf16_t*)(ws + WS_WQKV); bf16_t* Wo = (bf16_t*)(ws + WS_WO);
    bf16_t* Wgu0 = (bf16_t*)(ws + WS_WGU0); bf16_t* Wgu1 = (bf16_t*)(ws + WS_WGU1); bf16_t* Wd0 = (bf16_t*)(ws + WS_WD0); bf16_t* Wd1 = (bf16_t*)(ws + WS_WD1);
    bf16_t* X1 = (bf16_t*)a.out;
    float* RS1 = (float*)ws; float* RS2 = RS1 + MTOK; float* RS3 = RS2 + MTOK;
    bf16_t* XN = (bf16_t*)(ws + WS_XN); bf16_t* HB = (bf16_t*)(ws + WS_BIG); bf16_t* Q0 = (bf16_t*)(ws + WS_Q0); bf16_t* KB = (bf16_t*)(ws + WS_K);

    {
        LAS float* scr = (LAS float*)(lds + wave * 16384);
        constexpr int I_GLU = 32 * 64, I_Q = 32 * 96, I_KV = 32 * 64, I_O = 32 * 32, I_GU = 32 * 176, I_D = 88 * 32;
        constexpr int NITEMS = I_GLU + I_Q + I_KV + I_O + 2 * I_GU + 2 * I_D;
        for (int it = gw; it < NITEMS; it += NGW) {
            int r = it;
            if (r < I_GLU) { p0_item64(a.in[11], DM, 2 * DM, nullptr, Wglu, r, 1, DM, 0, scr, lane); continue; } r -= I_GLU;
            if (r < I_Q) { p0_item64(a.in[15], DM, 3 * DM, a.in[1] + DM, Wqkv, r, 0, 0, 0, scr, lane); continue; } r -= I_Q;
            if (r < I_KV) { p0_item64(a.in[13], DM, 2 * DM, a.in[12], Wqkv, r, 0, 0, 3 * DM, scr, lane); continue; } r -= I_KV;
            if (r < I_O) { p0_item64(a.in[17], DM, DM, nullptr, Wo, r, 0, 0, 0, scr, lane); continue; } r -= I_O;
            if (r < I_GU) { p0_item64(a.in[18], DM, 2 * DFF, a.in[2], Wgu0, r, 1, DFF, 0, scr, lane); continue; } r -= I_GU;
            if (r < I_GU) { p0_item64(a.in[18] + (size_t)DM * 2 * DFF, DM, 2 * DFF, a.in[2] + DM, Wgu1, r, 1, DFF, 0, scr, lane); continue; } r -= I_GU;
            if (r < I_D) { p0_item64(a.in[19], DFF, DM, nullptr, Wd0, r, 0, 0, 0, scr, lane); continue; } r -= I_D;
            p0_item64(a.in[19] + (size_t)DFF * DM, DFF, DM, nullptr, Wd1, r, 0, 0, 0, scr, lane);
        }
        for (int i = gw * 64 + lane; i < 3 * MTOK; i += NGW * 64) RS1[i] = 0.f;
        if (bx == 0) for (int i = tid; i < XCD_BAR_WORDS; i += NWAVES * 64) ((unsigned*)(ws + WS_BAR))[i] = 0u;
        bf16_t* U = (bf16_t*)(ws + WS_U);
        for (int m = gw; m < MTOK; m += 2 * NGW) {
            const int m2 = m + NGW; const f32x4* xa = (const f32x4*)(x_in + (size_t)m * DM) + lane; const f32x4* xb = (const f32x4*)(x_in + (size_t)m2 * DM) + lane;
            f32x4 va[8], vb[8]; float sa = 0.f, sb = 0.f;
#pragma unroll
            for (int j = 0; j < 8; ++j) va[j] = xa[64 * j];
#pragma unroll
            for (int j = 0; j < 8; ++j) vb[j] = xb[64 * j];
#pragma unroll
            for (int j = 0; j < 8; ++j) { sa += (va[j].x * va[j].x + va[j].y * va[j].y) + (va[j].z * va[j].z + va[j].w * va[j].w); sb += (vb[j].x * vb[j].x + vb[j].y * vb[j].y) + (vb[j].z * vb[j].z + vb[j].w * vb[j].w); }
            const float ra = 1.0f / sqrtf(wave_sum(sa) * (1.f / DM) + EPS), rb = 1.0f / sqrtf(wave_sum(sb) * (1.f / DM) + EPS);
            u32x2* oa = (u32x2*)(U + (size_t)m * DM) + lane; u32x2* ob = (u32x2*)(U + (size_t)m2 * DM) + lane;
#pragma unroll
            for (int j = 0; j < 8; ++j) { const f32x4 g = ((const f32x4*)a.in[1])[lane + 64 * j];
                u32x2 w; w.x = cvtpk(va[j].x * ra * g.x, va[j].y * ra * g.y); w.y = cvtpk(va[j].z * ra * g.z, va[j].w * ra * g.w); oa[64 * j] = w;
                w.x = cvtpk(vb[j].x * rb * g.x, vb[j].y * rb * g.y); w.y = cvtpk(vb[j].z * rb * g.z, vb[j].w * rb * g.w); ob[64 * j] = w; }
        }
    }
    grid.sync();
    const XcdBarrier xbar = xcd_barrier_post((unsigned*)(ws + WS_BAR), MISC + 8);
    for (int t = gw; t < SG * (NCH - 1); t += NGW) s5_task<false>(a, t % SG, t / SG, lds + wave * 10240, lane);
    xcd_barrier(xbar);
    for (int t = gw; t < SG * NCH; t += NGW) s5_task<true>(a, t % SG, t / SG, lds + wave * 10240, lane);
    xcd_barrier(xbar);
    { pg8::Gemm g{XN, Wglu, MTOK, 2 * DM, DM}; pg8::StaticOrder S; S.init(MTOK, 2 * DM, G, bx); pg8::EpiGluRes2 E{x_in, X1, RS1, DM};
      pg8::gemm_phase<pg8::EpiGluRes2, pg8::StaticOrder, true, true>(lds, g, S, E); }
    xcd_barrier(xbar);
    { pg8::Gemm g{X1, Wgu0, MTOK, 2 * DFF, DM}; pg8::StaticOrder S; S.init(MTOK, 2 * DFF, G, bx); pg8::EpiSwiglu2 E{HB, DFF, RS1, 1.f / DM, EPS};
      pg8::gemm_phase<pg8::EpiSwiglu2, pg8::StaticOrder, true, true>(lds, g, S, E); }
    xcd_barrier(xbar);
    { pg8::Gemm g{HB, Wd0, MTOK, DM, DFF}; pg8::StaticOrder S; S.init(MTOK, DM, G, bx); pg8::EpiResAddBf E{X1, XN, RS2, DM};
      pg8::gemm_phase<pg8::EpiResAddBf, pg8::StaticOrder, true, true>(lds, g, S, E); }
    xcd_barrier(xbar);
    { pg8::Gemm g{XN, Wqkv, MTOK, 5 * DM, DM}; pg8::StaticOrder S; S.init(MTOK, 5 * DM, G, bx); pg8::EpiQKV E{Q0, QKV_T, SEQ, HP, RS2, 1.f / DM, EPS, (PG8_LAS float*)(lds + LDS_STG), a.in[14]};
      pg8::gemm_phase<pg8::EpiQKV, pg8::StaticOrder, true, true>(lds, g, S, E); }
    xcd_barrier(xbar);
    for (int su = vcu; su < BATCH * NHEAD * (SEQ / 2048); su += G) {
        const int b = su / (NHEAD * 8), head = (su / 8) % NHEAD, Ts = (su % 8) * 2048;
        attn_shared(a, b, head, Ts, wave, lds, lane);
        __syncthreads();
    }
    xcd_barrier(xbar);
    { pg8::Gemm g{X1, Wo, MTOK, DM, DM}; pg8::StaticOrder S; S.init(MTOK, DM, G, bx); pg8::EpiResAddBf E{XN, XN, RS3, DM};
      pg8::gemm_phase<pg8::EpiResAddBf, pg8::StaticOrder, true, true>(lds, g, S, E); }
    xcd_barrier(xbar);
    { pg8::Gemm g{XN, Wgu1, MTOK, 2 * DFF, DM}; pg8::StaticOrder S; S.init(MTOK, 2 * DFF, G, bx); pg8::EpiSwiglu2 E{HB, DFF, RS3, 1.f / DM, EPS};
      pg8::gemm_phase<pg8::EpiSwiglu2, pg8::StaticOrder, true, true>(lds, g, S, E); }
    xcd_barrier(xbar);
    { pg8::Gemm g{HB, Wd1, MTOK, DM, DFF}; pg8::StaticOrder S; S.init(MTOK, DM, G, bx); pg8::EpiResAddF32 E{XN, xo, DM};
      pg8::gemm_phase<pg8::EpiResAddF32, pg8::StaticOrder, true, true>(lds, g, S, E); }
}

extern "C" void kernel_launch(void* const* d_in, const int* in_sizes, int n_in, void* d_out, int out_size, void* d_ws, size_t ws_size, hipStream_t stream) {
    static int grid = 0;
    if (grid == 0) {
        if (n_in != 20 || out_size != MTOK * DM || ws_size < WS_END) { fprintf(stderr, "kernel_launch: unexpected problem (n_in %d out %d ws %zu)\n", n_in, out_size, ws_size); grid = -1; return; }
        int dev = 0, cus = 0, per_cu = 0;
        hipGetDevice(&dev); hipDeviceGetAttribute(&cus, hipDeviceAttributeMultiprocessorCount, dev);
        if (hipFuncSetAttribute((const void*)mega_fwd, hipFuncAttributeMaxDynamicSharedMemorySize, LDS_BYTES) != hipSuccess) { fprintf(stderr, "kernel_launch: hipFuncSetAttribute failed\n"); grid = -1; return; }
        if (hipOccupancyMaxActiveBlocksPerMultiprocessor(&per_cu, (const void*)mega_fwd, NWAVES * 64, LDS_BYTES) != hipSuccess || per_cu < 1) { fprintf(stderr, "kernel_launch: occupancy query says %d\n", per_cu); per_cu = 1; }
        (void)hipGetLastError();
        grid = cus * 1;
    }
    if (grid < 0) return;
    Args a{};
    for (int i = 0; i < 20; ++i) a.in[i] = (const float*)d_in[i];
    a.out = (float*)d_out; a.ws = (unsigned char*)d_ws;
    void* args[] = {&a};
    hipError_t e = hipLaunchCooperativeKernel((const void*)mega_fwd, dim3(grid), dim3(NWAVES * 64), args, LDS_BYTES, stream);
    if (e != hipSuccess) fprintf(stderr, "kernel_launch: cooperative launch failed: %s (grid %d)\n", hipGetErrorString(e), grid);
}
```

```cpp
#include <hip/hip_runtime.h>
#include <hip/hip_cooperative_groups.h>
#include <cstdio>
#include <cstdint>
#include <cmath>
namespace cg = cooperative_groups;
namespace pg8 {
#define PG8_LAS __attribute__((address_space(3)))
typedef unsigned short bf16_t;
typedef short bf16x8 __attribute__((ext_vector_type(8)));
typedef float f32x4 __attribute__((ext_vector_type(4)));
typedef unsigned u32x4 __attribute__((ext_vector_type(4)));
constexpr int BM = 256, BK = 64, HALF = 128, HTB = HALF * BK * 2  , STAGE_BYTES = 8 * HTB, NXCD = 8, WGM = 4;

__host__ __device__ __forceinline__ int lds_byte(int r, int c) { const int st = (r >> 4) * 2 + (c >> 5), rr = r & 15, cc = c & 31, ob = rr * 64 + cc * 2; return st * 1024 + (ob ^ (((ob >> 9) & 1) << 5)); }
__host__ __device__ __forceinline__ void stage_rc(int b, int& R, int& C) { const int st = b / 1024, sb = b % 1024, swz = sb ^ (((sb >> 9) & 1) << 5); R = (st >> 1) * 16 + swz / 64; C = (st & 1) * 32 + (swz % 64) / 2; }
__host__ __device__ __forceinline__ int perm32(int rho) { const int n = rho >> 4, i = rho & 15; return 8 * (i >> 2) + 4 * n + (i & 3); }

struct Unit { int pm, pn; };
struct Gemm { const bf16_t* A; const bf16_t* Bt; int M, N, K; };

struct StaticOrder {
    int nM, nN, nwg, G, c;
    __host__ __device__ void init(int M, int N, int G_, int c_) { nM = M / BM; nN = N / BM; nwg = nM * nN; G = G_; c = c_; }
    __host__ __device__ bool next(int i, Unit& u) const {
        const long L = (long)i * G + c; if (L >= nwg) return false;
        int wgid = (int)L; { const int q = nwg / NXCD, r = nwg % NXCD, xcd = wgid % NXCD, off = wgid / NXCD; wgid = (xcd < r ? xcd * (q + 1) : r * (q + 1) + (xcd - r) * q) + off; }
        const int nig = WGM * nN, gid = wgid / nig, fm = gid * WGM, gsz = (nM - fm) < WGM ? (nM - fm) : WGM;
        u.pm = fm + ((wgid % nig) % gsz); u.pn = (wgid % nig) / gsz; return true;
    }
    __device__ __forceinline__ void a_ready(const Unit&) const {}
    __device__ __forceinline__ void done(const Unit&) const {}
};

__device__ __forceinline__ unsigned cvt_pk_bf16(float lo, float hi) { unsigned r; asm volatile("v_cvt_pk_bf16_f32 %0, %1, %2" : "=v"(r) : "v"(lo), "v"(hi)); return r; }
typedef float f32x2 __attribute__((ext_vector_type(2)));
__device__ __forceinline__ f32x2 gelu_pk(f32x2 v) {
    const f32x2 av = __builtin_elementwise_abs(v), d = av * 0.2316418882f + 1.0f;
    f32x2 t; t.x = __builtin_amdgcn_rcpf(d.x); t.y = __builtin_amdgcn_rcpf(d.y);
    f32x2 q = t * 0.5307027145f + (-0.7265760135f); q = q * t + 0.7107068705f; q = q * t + (-0.142248368f); q = q * t + 0.127414796f; q = q * t;
    const f32x2 s = (v * v) * (-0.72134752044f);
    f32x2 e; e.x = __builtin_amdgcn_exp2f(s.x); e.y = __builtin_amdgcn_exp2f(s.y);
    const f32x2 m = v * (q * e), r = v - m;
    f32x2 o; o.x = v.x < 0.f ? m.x : r.x; o.y = v.y < 0.f ? m.y : r.y; return o;
}

template <int ACT  > struct EpiBf16 {
    static constexpr bool PERM = true, AFTER_DRAIN = false; static_assert(ACT == 0 || ACT == 1, "EpiBf16: ACT is 0 (none) or 1 (gelu_pk)");
    bf16_t* O; int ldc; const float* bias; int split_cols; size_t split_stride; float scale0;
    __device__ __forceinline__ void operator()(const f32x4 (&acc)[2][2][4][2], const Unit& u, int wr, int wc, int fr, int fq) const {
        const int row0 = u.pm * BM + wr * 64 + fr; int colt = u.pn * BM; bf16_t* base = O;
        float sc = 1.f; if (split_cols) { const int t = colt / split_cols; base += (size_t)t * split_stride; colt -= t * split_cols; if (t == 0) sc = scale0; }
        const int col0 = colt + wc * 32 + 8 * fq, bcol0 = u.pn * BM + wc * 32 + 8 * fq;
        f32x4 bv[2][2];
#pragma unroll
        for (int bj = 0; bj < 2; ++bj)
#pragma unroll
            for (int n = 0; n < 2; ++n) bv[bj][n] = bias ? *(const f32x4*)(bias + bcol0 + bj * HALF + 4 * n) : (f32x4){0.f, 0.f, 0.f, 0.f};
#pragma unroll
        for (int ai = 0; ai < 2; ++ai)
#pragma unroll
            for (int m = 0; m < 4; ++m) { bf16_t* rowp = base + (size_t)(row0 + ai * HALF + m * 16) * ldc + col0;
#pragma unroll
                for (int bj = 0; bj < 2; ++bj) { f32x4 v0 = acc[ai][bj][m][0] + bv[bj][0], v1 = acc[ai][bj][m][1] + bv[bj][1];
                    if (ACT == 1) { f32x2 a = gelu_pk((f32x2){v0[0], v0[1]}), b = gelu_pk((f32x2){v0[2], v0[3]}), c = gelu_pk((f32x2){v1[0], v1[1]}), d = gelu_pk((f32x2){v1[2], v1[3]});
                        v0 = (f32x4){a.x, a.y, b.x, b.y}; v1 = (f32x4){c.x, c.y, d.x, d.y}; }
                    v0 = v0 * sc; v1 = v1 * sc; u32x4 w; w.x = cvt_pk_bf16(v0[0], v0[1]); w.y = cvt_pk_bf16(v0[2], v0[3]); w.z = cvt_pk_bf16(v1[0], v1[1]); w.w = cvt_pk_bf16(v1[2], v1[3]);
                    *(u32x4*)(rowp + bj * HALF) = w; } }
    }
};
typedef unsigned u32x2e __attribute__((ext_vector_type(2)));
__device__ __forceinline__ float sigmoid_f(float x) { return __builtin_amdgcn_rcpf(1.0f + __builtin_amdgcn_exp2f(-1.4426950408889634f * x)); }
struct EpiGluRes {
    static constexpr bool PERM = true, AFTER_DRAIN = false;
    const float* resid; float* out; int ldc;
    __device__ __forceinline__ void operator()(const f32x4 (&acc)[2][2][4][2], const Unit& u, int wr, int wc, int fr, int fq) const {
        const int row0 = u.pm * BM + wr * 64 + fr, col0 = u.pn * HALF + wc * 32 + 8 * fq;
#pragma unroll
        for (int ai = 0; ai < 2; ++ai)
#pragma unroll
            for (int m = 0; m < 4; ++m) { const size_t off = (size_t)(row0 + ai * HALF + m * 16) * ldc + col0;
#pragma unroll
                for (int n = 0; n < 2; ++n) { const f32x4 r = *(const f32x4*)(resid + off + 4 * n); const f32x4 v = acc[ai][0][m][n], g = acc[ai][1][m][n]; f32x4 o;
                    o[0] = r[0] + v[0] * sigmoid_f(g[0]); o[1] = r[1] + v[1] * sigmoid_f(g[1]); o[2] = r[2] + v[2] * sigmoid_f(g[2]); o[3] = r[3] + v[3] * sigmoid_f(g[3]);
                    *(f32x4*)(out + off + 4 * n) = o; } }
    }
};
struct EpiSwiglu {
    static constexpr bool PERM = true, AFTER_DRAIN = false;
    bf16_t* O; int ldc;
    __device__ __forceinline__ void operator()(const f32x4 (&acc)[2][2][4][2], const Unit& u, int wr, int wc, int fr, int fq) const {
        const int row0 = u.pm * BM + wr * 64 + fr, col0 = u.pn * HALF + wc * 32 + 8 * fq;
#pragma unroll
        for (int ai = 0; ai < 2; ++ai)
#pragma unroll
            for (int m = 0; m < 4; ++m) { bf16_t* rowp = O + (size_t)(row0 + ai * HALF + m * 16) * ldc + col0;
                float h[8];
#pragma unroll
                for (int n = 0; n < 2; ++n)
#pragma unroll
                    for (int e = 0; e < 4; ++e) { const float g = acc[ai][0][m][n][e], up = acc[ai][1][m][n][e]; h[4 * n + e] = g * sigmoid_f(g) * up; }
                u32x4 w; w.x = cvt_pk_bf16(h[0], h[1]); w.y = cvt_pk_bf16(h[2], h[3]); w.z = cvt_pk_bf16(h[4], h[5]); w.w = cvt_pk_bf16(h[6], h[7]);
                *(u32x4*)rowp = w; }
    }
};
struct EpiResAdd {
    static constexpr bool PERM = true, AFTER_DRAIN = false;
    const float* resid; float* out; int ldc;
    __device__ __forceinline__ void operator()(const f32x4 (&acc)[2][2][4][2], const Unit& u, int wr, int wc, int fr, int fq) const {
        const int row0 = u.pm * BM + wr * 64 + fr, col0 = u.pn * BM + wc * 32 + 8 * fq;
#pragma unroll
        for (int ai = 0; ai < 2; ++ai)
#pragma unroll
            for (int m = 0; m < 4; ++m) { const size_t off = (size_t)(row0 + ai * HALF + m * 16) * ldc + col0;
#pragma unroll
                for (int bj = 0; bj < 2; ++bj)
#pragma unroll
                    for (int n = 0; n < 2; ++n) { const f32x4 r = *(const f32x4*)(resid + off + bj * HALF + 4 * n); *(f32x4*)(out + off + bj * HALF + 4 * n) = r + acc[ai][bj][m][n]; } }
    }
};

__device__ __forceinline__ float bfl(unsigned w) { return __builtin_bit_cast(float, w << 16); }
__device__ __forceinline__ float bfh(unsigned w) { return __builtin_bit_cast(float, w & 0xffff0000u); }
__device__ __forceinline__ void ss_add(float* ss, int row, float s, int fq) {
    s += __shfl_xor(s, 16); s += __shfl_xor(s, 32);
    if (fq == 0) __hip_atomic_fetch_add(ss + row, s, __ATOMIC_RELAXED, __HIP_MEMORY_SCOPE_AGENT);
}
struct EpiGluRes2 {
    static constexpr bool PERM = true, AFTER_DRAIN = false;
    const float* resid; bf16_t* out; float* ss; int ldc;
    __device__ __forceinline__ void operator()(const f32x4 (&acc)[2][2][4][2], const Unit& u, int wr, int wc, int fr, int fq) const {
        const int row0 = u.pm * BM + wr * 64 + fr, col0 = u.pn * HALF + wc * 32 + 8 * fq;
#pragma unroll
        for (int ai = 0; ai < 2; ++ai)
#pragma unroll
            for (int m = 0; m < 4; ++m) { const int row = row0 + ai * HALF + m * 16; const size_t off = (size_t)row * ldc + col0; float o[8]; float s = 0.f;
#pragma unroll
                for (int n = 0; n < 2; ++n) { const f32x4 r = *(const f32x4*)(resid + off + 4 * n); const f32x4 v = acc[ai][0][m][n], g = acc[ai][1][m][n];
#pragma unroll
                    for (int e = 0; e < 4; ++e) { const float x = r[e] + v[e] * sigmoid_f(g[e]); o[4 * n + e] = x; s += x * x; } }
                u32x4 w; w.x = cvt_pk_bf16(o[0], o[1]); w.y = cvt_pk_bf16(o[2], o[3]); w.z = cvt_pk_bf16(o[4], o[5]); w.w = cvt_pk_bf16(o[6], o[7]);
                *(u32x4*)(out + off) = w; ss_add(ss, row, s, fq); }
    }
};
struct EpiResAddBf {
    static constexpr bool PERM = true, AFTER_DRAIN = false;
    const bf16_t* resid; bf16_t* out; float* ss; int ldc;
    __device__ __forceinline__ void operator()(const f32x4 (&acc)[2][2][4][2], const Unit& u, int wr, int wc, int fr, int fq) const {
        const int row0 = u.pm * BM + wr * 64 + fr, col0 = u.pn * BM + wc * 32 + 8 * fq;
#pragma unroll
        for (int ai = 0; ai < 2; ++ai)
#pragma unroll
            for (int m = 0; m < 4; ++m) { const int row = row0 + ai * HALF + m * 16; const size_t off = (size_t)row * ldc + col0; float s = 0.f;
#pragma unroll
                for (int bj = 0; bj < 2; ++bj) { const u32x4 r = *(const u32x4*)(resid + off + bj * HALF); const f32x4 a0 = acc[ai][bj][m][0], a1 = acc[ai][bj][m][1];
                    const float o0 = bfl(r.x) + a0[0], o1 = bfh(r.x) + a0[1], o2 = bfl(r.y) + a0[2], o3 = bfh(r.y) + a0[3], o4 = bfl(r.z) + a1[0], o5 = bfh(r.z) + a1[1], o6 = bfl(r.w) + a1[2], o7 = bfh(r.w) + a1[3];
                    s += (o0 * o0 + o1 * o1) + (o2 * o2 + o3 * o3) + (o4 * o4 + o5 * o5) + (o6 * o6 + o7 * o7);
                    u32x4 w; w.x = cvt_pk_bf16(o0, o1); w.y = cvt_pk_bf16(o2, o3); w.z = cvt_pk_bf16(o4, o5); w.w = cvt_pk_bf16(o6, o7);
                    *(u32x4*)(out + off + bj * HALF) = w; }
                ss_add(ss, row, s, fq); }
    }
};
struct EpiResAddF32 {
    static constexpr bool PERM = true, AFTER_DRAIN = false;
    const bf16_t* resid; float* out; int ldc;
    __device__ __forceinline__ void operator()(const f32x4 (&acc)[2][2][4][2], const Unit& u, int wr, int wc, int fr, int fq) const {
        const int row0 = u.pm * BM + wr * 64 + fr, col0 = u.pn * BM + wc * 32 + 8 * fq;
#pragma unroll
        for (int ai = 0; ai < 2; ++ai)
#pragma unroll
            for (int m = 0; m < 4; ++m) { const size_t off = (size_t)(row0 + ai * HALF + m * 16) * ldc + col0;
#pragma unroll
                for (int bj = 0; bj < 2; ++bj) { const u32x4 r = *(const u32x4*)(resid + off + bj * HALF); const f32x4 a0 = acc[ai][bj][m][0], a1 = acc[ai][bj][m][1];
                    *(f32x4*)(out + off + bj * HALF) = (f32x4){bfl(r.x) + a0[0], bfh(r.x) + a0[1], bfl(r.y) + a0[2], bfh(r.y) + a0[3]};
                    *(f32x4*)(out + off + bj * HALF + 4) = (f32x4){bfl(r.z) + a1[0], bfh(r.z) + a1[1], bfl(r.w) + a1[2], bfh(r.w) + a1[3]}; } }
    }
};
struct EpiSwiglu2 {
    static constexpr bool PERM = true, AFTER_DRAIN = false;
    bf16_t* O; int ldc; const float* ss; float inv_n, eps;
    __device__ __forceinline__ void operator()(const f32x4 (&acc)[2][2][4][2], const Unit& u, int wr, int wc, int fr, int fq) const {
        const int row0 = u.pm * BM + wr * 64 + fr, col0 = u.pn * HALF + wc * 32 + 8 * fq;
#pragma unroll
        for (int ai = 0; ai < 2; ++ai)
#pragma unroll
            for (int m = 0; m < 4; ++m) { const int row = row0 + ai * HALF + m * 16; bf16_t* rowp = O + (size_t)row * ldc + col0; const float rs = __builtin_amdgcn_rsqf(ss[row] * inv_n + eps);
                float h[8];
#pragma unroll
                for (int n = 0; n < 2; ++n)
#pragma unroll
                    for (int e = 0; e < 4; ++e) { const float g = acc[ai][0][m][n][e] * rs, up = acc[ai][1][m][n][e] * rs; h[4 * n + e] = g * sigmoid_f(g) * up; }
                u32x4 w; w.x = cvt_pk_bf16(h[0], h[1]); w.y = cvt_pk_bf16(h[2], h[3]); w.z = cvt_pk_bf16(h[4], h[5]); w.w = cvt_pk_bf16(h[6], h[7]);
                *(u32x4*)rowp = w; }
    }
};

struct EpiQKV {
    static constexpr bool PERM = true, AFTER_DRAIN = false;
    bf16_t* base; size_t tstride; int seq, pitch; const float* ss; float inv_n, eps; PG8_LAS float* kscr; const float* kgain;
    __device__ __forceinline__ void operator()(const f32x4 (&acc)[2][2][4][2], const Unit& u, int wr, int wc, int fr, int fq) const {
        const int colt = u.pn * BM, t = colt >> 11, head0 = (colt & 2047) >> 7, d = wc * 32 + 8 * fq;
        const int rowt = u.pm * BM, b = rowt / seq, tok0 = rowt - b * seq + wr * 64 + fr;
        bf16_t* tb = base + (size_t)t * tstride;
        const bool isk = (t == 3);
        float rs[2][4];
#pragma unroll
        for (int ai = 0; ai < 2; ++ai)
#pragma unroll
            for (int m = 0; m < 4; ++m) rs[ai][m] = __builtin_amdgcn_rsqf(ss[rowt + wr * 64 + fr + ai * HALF + m * 16] * inv_n + eps);
        f32x4 kg0 = {1.f, 1.f, 1.f, 1.f}, kg1 = {1.f, 1.f, 1.f, 1.f};
        if (isk) {
            kg0 = *(const f32x4*)(kgain + d); kg1 = *(const f32x4*)(kgain + d + 4);
#pragma unroll
            for (int bj = 0; bj < 2; ++bj)
#pragma unroll
                for (int ai = 0; ai < 2; ++ai)
#pragma unroll
                    for (int m = 0; m < 4; ++m) { const f32x4 v0 = acc[ai][bj][m][0] * rs[ai][m], v1 = acc[ai][bj][m][1] * rs[ai][m];
                        float s = (v0[0] * v0[0] + v0[1] * v0[1]) + (v0[2] * v0[2] + v0[3] * v0[3]) + (v1[0] * v1[0] + v1[1] * v1[1]) + (v1[2] * v1[2] + v1[3] * v1[3]);
                        s += __shfl_xor(s, 16); s += __shfl_xor(s, 32);
                        if (fq == 0) kscr[((ai * HALF + wr * 64 + m * 16 + fr) * 2 + bj) * 4 + wc] = s; }
            asm volatile("s_waitcnt lgkmcnt(0)" ::: "memory"); __builtin_amdgcn_s_barrier(); asm volatile("" ::: "memory");
        }
#pragma unroll
        for (int bj = 0; bj < 2; ++bj) { bf16_t* hb = tb + ((size_t)(b * 16 + head0 + bj) * seq) * pitch + d;
#pragma unroll
            for (int ai = 0; ai < 2; ++ai)
#pragma unroll
                for (int m = 0; m < 4; ++m) { float sc = rs[ai][m];
                    if (isk) { const f32x4 p = *(const PG8_LAS f32x4*)(kscr + ((ai * HALF + wr * 64 + m * 16 + fr) * 2 + bj) * 4); sc *= __builtin_amdgcn_rsqf(((p[0] + p[1]) + (p[2] + p[3])) * (1.0f / 128.0f) + eps); }
                    const f32x4 v0 = acc[ai][bj][m][0] * sc * kg0, v1 = acc[ai][bj][m][1] * sc * kg1;
                    u32x4 w; w.x = cvt_pk_bf16(v0[0], v0[1]); w.y = cvt_pk_bf16(v0[2], v0[3]); w.z = cvt_pk_bf16(v1[0], v1[1]); w.w = cvt_pk_bf16(v1[2], v1[3]);
                    *(u32x4*)(hb + (size_t)(tok0 + ai * HALF + m * 16) * pitch) = w; } }
    }
};
template <class Epi, class Sched, bool ALIGN_EPI = false, bool SP2 = false>
__device__ __forceinline__ void gemm_phase(PG8_LAS unsigned char* lds, const Gemm g, const Sched& S, const Epi& E) {
    int tid_ = threadIdx.x; asm volatile("" : "+v"(tid_));
    const int tid = tid_, wid = __builtin_amdgcn_readfirstlane(tid >> 6), lane = tid & 63, wr = wid >> 2, wc = wid & 3, fr = lane & 15, fq = lane >> 4;
    const int K = g.K, nt = K / BK;
    unsigned voffA[2], voffB[2];
#pragma unroll
    for (int i = 0; i < 2; ++i) { int R, C; stage_rc(tid * 16 + i * 8192, R, C); const int Rb = Epi::PERM ? ((R & ~31) + perm32(R & 31)) : R;
        voffA[i] = (unsigned)(R * K + C) * 2u; voffB[i] = (unsigned)(Rb * K + C) * 2u; }
    const size_t kstep = (size_t)(BK * 2);
    const size_t hstep = (size_t)HALF * K * 2;
    const size_t tstep = 2 * hstep;
    const unsigned ldsw = (unsigned)wid * 1024u;
    const int aoff = lds_byte(wr * 64 + fr, fq * 8), boff = lds_byte(wc * 32 + fr, fq * 8);
#define PG8_SA(b, h) (((b) * 2 + (h)) * HTB)
#define PG8_SB(b, h) ((4 + (b) * 2 + (h)) * HTB)
#define PG8_STAGE(bufoff, gbase, voff) do { _Pragma("unroll") for (int _i = 0; _i < 2; ++_i) \
        __builtin_amdgcn_global_load_lds((const unsigned*)((const char*)(gbase) + (voff)[_i]), (PG8_LAS unsigned*)(lds + (bufoff) + ldsw + _i * 8192), 16, 0, 0); } while (0)
#define PG8_LDA(dst, b, h) do { _Pragma("unroll") for (int m = 0; m < 4; ++m) _Pragma("unroll") for (int k = 0; k < 2; ++k) dst[m][k] = *(const PG8_LAS bf16x8*)(lds + PG8_SA(b, h) + aoff + m * 2048 + k * 1024); } while (0)
#define PG8_LDB(dst, b, h) do { _Pragma("unroll") for (int n = 0; n < 2; ++n) _Pragma("unroll") for (int k = 0; k < 2; ++k) dst[n][k] = *(const PG8_LAS bf16x8*)(lds + PG8_SB(b, h) + boff + n * 2048 + k * 1024); } while (0)
#define PG8_MMA(ai, bj, At, Bt) do { __builtin_amdgcn_s_setprio(1); _Pragma("unroll") for (int m = 0; m < 4; ++m) _Pragma("unroll") for (int n = 0; n < 2; ++n) _Pragma("unroll") for (int k = 0; k < 2; ++k) \
        acc[ai][bj][m][n] = __builtin_amdgcn_mfma_f32_16x16x32_bf16(Bt[n][k], At[m][k], acc[ai][bj][m][n], 0, 0, 0); __builtin_amdgcn_s_setprio(0); } while (0)
#define PG8_WAIT_V(n) asm volatile("s_waitcnt vmcnt(" #n ")" ::: "memory")
#define PG8_WAIT_L(n) asm volatile("s_waitcnt lgkmcnt(" #n ")" ::: "memory")
#define PG8_BAR __builtin_amdgcn_s_barrier()
#define PG8_SCHED __builtin_amdgcn_sched_barrier(0)
    Unit cur, nxt; int ui = 0;
    if (!S.next(0, cur)) return;
    f32x4 acc[2][2][4][2];
#pragma unroll
    for (int a = 0; a < 2; ++a)
#pragma unroll
        for (int b = 0; b < 2; ++b)
#pragma unroll
            for (int m = 0; m < 4; ++m)
#pragma unroll
                for (int n = 0; n < 2; ++n) acc[a][b][m][n] = (f32x4){0.f, 0.f, 0.f, 0.f};
    bf16x8 At[4][2], B0[2][2], B1[2][2];
    const char* cA = (const char*)g.A + (size_t)cur.pm * tstep; const char* cB = (const char*)g.Bt + (size_t)cur.pn * tstep;
    S.a_ready(cur);
    if constexpr (SP2) {
        PG8_STAGE(PG8_SB(0, 0), cB, voffB); PG8_STAGE(PG8_SB(0, 1), cB + hstep, voffB); PG8_STAGE(PG8_SA(0, 0), cA, voffA); PG8_STAGE(PG8_SA(0, 1), cA + hstep, voffA);
        if (wr == 1) PG8_BAR;
        PG8_WAIT_V(2); PG8_BAR;
        PG8_STAGE(PG8_SB(1, 0), cB + kstep, voffB); PG8_STAGE(PG8_SA(1, 0), cA + kstep, voffA); PG8_STAGE(PG8_SB(1, 1), cB + hstep + kstep, voffB);
        PG8_WAIT_V(6); PG8_BAR;
    } else {
        PG8_STAGE(PG8_SB(0, 0), cB, voffB); PG8_STAGE(PG8_SA(0, 0), cA, voffA); PG8_STAGE(PG8_SB(0, 1), cB + hstep, voffB); PG8_STAGE(PG8_SA(0, 1), cA + hstep, voffA);
        if (wr == 1) PG8_BAR;
        PG8_WAIT_V(4); PG8_BAR;
        PG8_STAGE(PG8_SB(1, 0), cB + kstep, voffB); PG8_STAGE(PG8_SA(1, 0), cA + kstep, voffA); PG8_STAGE(PG8_SB(1, 1), cB + hstep + kstep, voffB);
        PG8_WAIT_V(6); PG8_BAR;
    }
    for (;;) {
        const bool has_next = S.next(ui + 1, nxt);
        const char* nA = has_next ? (const char*)g.A + (size_t)nxt.pm * tstep : cA; const char* nB = has_next ? (const char*)g.Bt + (size_t)nxt.pn * tstep : cB;
        for (int t = 0; t < nt; t += 2) {
            const bool last = (t == nt - 2);
            const char* a1 = cA + (size_t)(t + 1) * kstep;
            const char* a2 = last ? nA : cA + (size_t)(t + 2) * kstep; const char* b2 = last ? nB : cB + (size_t)(t + 2) * kstep;
            const char* a3 = a2 + kstep; const char* b3 = b2 + kstep;
            if (last && has_next) S.a_ready(nxt);
            if constexpr (SP2) {
            PG8_LDB(B0, 0, 0); PG8_LDB(B1, 0, 1); PG8_SCHED; PG8_LDA(At, 0, 0); PG8_STAGE(PG8_SA(1, 1), a1 + hstep, voffA);
            PG8_WAIT_V(8); PG8_WAIT_L(0); PG8_BAR; PG8_MMA(0, 0, At, B0); PG8_MMA(0, 1, At, B1); PG8_BAR; PG8_SCHED;
            PG8_LDA(At, 0, 1); PG8_STAGE(PG8_SB(0, 0), b2, voffB); PG8_STAGE(PG8_SB(0, 1), b2 + hstep, voffB); PG8_STAGE(PG8_SA(0, 0), a2, voffA);
            PG8_WAIT_V(8); PG8_WAIT_L(0); PG8_BAR; PG8_MMA(1, 0, At, B0); PG8_MMA(1, 1, At, B1); PG8_BAR; PG8_SCHED;
            PG8_LDB(B0, 1, 0); PG8_LDB(B1, 1, 1); PG8_SCHED; PG8_LDA(At, 1, 0); PG8_STAGE(PG8_SA(0, 1), a2 + hstep, voffA);
            PG8_WAIT_V(8); PG8_WAIT_L(0); PG8_BAR; PG8_MMA(0, 0, At, B0); PG8_MMA(0, 1, At, B1); PG8_BAR; PG8_SCHED;
            PG8_LDA(At, 1, 1); PG8_STAGE(PG8_SB(1, 0), b3, voffB); PG8_STAGE(PG8_SB(1, 1), b3 + hstep, voffB); PG8_STAGE(PG8_SA(1, 0), a3, voffA);
            PG8_WAIT_V(8); PG8_WAIT_L(0); PG8_BAR; PG8_MMA(1, 0, At, B0); PG8_MMA(1, 1, At, B1); PG8_BAR; PG8_SCHED;
            } else {
            PG8_LDB(B0, 0, 0); PG8_SCHED; PG8_LDA(At, 0, 0); PG8_STAGE(PG8_SA(1, 1), a1 + hstep, voffA);
            PG8_WAIT_L(8); PG8_BAR; PG8_WAIT_L(0); PG8_MMA(0, 0, At, B0); PG8_BAR; PG8_SCHED;
            PG8_LDB(B1, 0, 1); PG8_STAGE(PG8_SB(0, 0), b2, voffB);
            PG8_BAR; PG8_WAIT_L(0); PG8_MMA(0, 1, At, B1); PG8_BAR;
            PG8_LDA(At, 0, 1); PG8_STAGE(PG8_SA(0, 0), a2, voffA);
            PG8_BAR; PG8_WAIT_L(0); PG8_MMA(1, 0, At, B0); PG8_BAR; PG8_SCHED;
            PG8_STAGE(PG8_SB(0, 1), b2 + hstep, voffB);
            PG8_WAIT_V(6); PG8_BAR; PG8_MMA(1, 1, At, B1); PG8_BAR;
            PG8_LDB(B0, 1, 0); PG8_SCHED; PG8_LDA(At, 1, 0); PG8_STAGE(PG8_SA(0, 1), a2 + hstep, voffA);
            PG8_WAIT_L(8); PG8_BAR; PG8_WAIT_L(0); PG8_MMA(0, 0, At, B0); PG8_BAR; PG8_SCHED;
            PG8_LDB(B1, 1, 1); PG8_STAGE(PG8_SB(1, 0), b3, voffB);
            PG8_BAR; PG8_WAIT_L(0); PG8_MMA(0, 1, At, B1); PG8_BAR;
            PG8_LDA(At, 1, 1); PG8_STAGE(PG8_SA(1, 0), a3, voffA);
            PG8_BAR; PG8_WAIT_L(0); PG8_MMA(1, 0, At, B0); PG8_BAR; PG8_SCHED;
            PG8_STAGE(PG8_SB(1, 1), b3 + hstep, voffB);
            PG8_WAIT_V(6); PG8_BAR; PG8_MMA(1, 1, At, B1); PG8_BAR;
            }
        }
        if constexpr (ALIGN_EPI) { if (wr == 0) PG8_BAR; }
        if constexpr (!Epi::AFTER_DRAIN) { E(acc, cur, wr, wc, fr, fq); S.done(cur); }
        if (!has_next) break;
#pragma unroll
        for (int a = 0; a < 2; ++a)
#pragma unroll
            for (int b = 0; b < 2; ++b)
#pragma unroll
                for (int m = 0; m < 4; ++m)
#pragma unroll
                    for (int n = 0; n < 2; ++n) acc[a][b][m][n] = (f32x4){0.f, 0.f, 0.f, 0.f};
        cur = nxt; cA = nA; cB = nB; ++ui;
        if constexpr (ALIGN_EPI) { if (wr == 1) PG8_BAR; }
    }
    PG8_WAIT_V(0);
    if constexpr (!ALIGN_EPI) { if (wr == 0) PG8_BAR; }
    PG8_BAR;
    if constexpr (Epi::AFTER_DRAIN) { E.fused(acc, cur, wr, wc, fr, fq, lds, wid, lane); S.done(cur); }
#undef PG8_SA
#undef PG8_SB
#undef PG8_STAGE
#undef PG8_LDA
#undef PG8_LDB
#undef PG8_MMA
#undef PG8_WAIT_V
#undef PG8_WAIT_L
#undef PG8_BAR
#undef PG8_SCHED
}
}

#define LAS __attribute__((address_space(3)))
typedef unsigned short bf16_t;
typedef short bf16x8 __attribute__((ext_vector_type(8)));
typedef short s16x4 __attribute__((ext_vector_type(4)));
typedef float f32x4 __attribute__((ext_vector_type(4)));
typedef float f32x16 __attribute__((ext_vector_type(16)));
typedef unsigned u32x4 __attribute__((ext_vector_type(4)));
typedef unsigned u32x2 __attribute__((ext_vector_type(2)));
typedef float f32x2_t __attribute__((ext_vector_type(2)));
typedef __bf16 bf16x2_t __attribute__((ext_vector_type(2)));

constexpr int BATCH = 2, SEQ = 16384, DM = 2048, MTOK = BATCH * SEQ, DFF = 5632;
constexpr int SG = 128, SP = 64, SH = 16, SCH = 256, NCH = SEQ / SCH;
constexpr int NHEAD = 16, HD = 128;
constexpr float EPS = 1e-6f;
constexpr int NWAVES = 8;
constexpr size_t MiB = 1u << 20;
constexpr size_t WS_WGLU = 4 * MiB, WS_WQKV = 20 * MiB, WS_WO = 60 * MiB, WS_WGU0 = 68 * MiB, WS_WGU1 = 112 * MiB, WS_WD0 = 156 * MiB, WS_WD1 = 178 * MiB;
constexpr int HP = 128;
constexpr size_t QKV_T = (size_t)BATCH * 16 * SEQ * HP;
constexpr size_t WS_XN = 200 * MiB, WS_BIG = 328 * MiB, WS_Q0 = WS_BIG, WS_Q1 = WS_BIG + 2 * QKV_T, WS_Q2 = WS_BIG + 4 * QKV_T, WS_K = WS_BIG + 6 * QKV_T, WS_V = WS_BIG + 8 * QKV_T;
constexpr size_t WS_LSE = 1008 * MiB, WS_END = 1012 * MiB;
constexpr size_t WS_U = WS_BIG, WS_SST = WS_BIG + 128 * MiB;
constexpr int LDS_BYTES = 157696;
constexpr int LDS_STG = 135168, STG_WAVE = 2816, STG_PITCH = 80;
constexpr size_t WS_BAR = 2 * MiB;

__device__ __forceinline__ unsigned cvtpk(float lo, float hi) { f32x2_t v = {lo, hi}; bf16x2_t b = __builtin_convertvector(v, bf16x2_t); return __builtin_bit_cast(unsigned, b); }
__device__ __forceinline__ float bf_lo(unsigned w) { return __builtin_bit_cast(float, w << 16); }
__device__ __forceinline__ float bf_hi(unsigned w) { return __builtin_bit_cast(float, w & 0xffff0000u); }
__device__ __forceinline__ float wave_sum(float v) {
#pragma unroll
    for (int o = 1; o < 64; o <<= 1) v += __shfl_xor(v, o);
    return v;
}
__device__ __forceinline__ int crow(int r, int h) { return (r & 3) + 8 * (r >> 2) + 4 * h; }

struct Args { const float* in[20]; float* out; unsigned char* ws; };

__device__ __forceinline__ void p0_item(const float* W, int K, int N, const float* gain, bf16_t* WT, int item, int mode, int Hn, int row_off, LAS float* scr, int lane) {
    const int nblk = N / 32, kb = item / nblk, nb = item % nblk, k0 = 64 * kb, n0 = 32 * nb;
#pragma unroll 8
    for (int i = 0; i < 32; ++i) { const int kk = 2 * i + (lane >> 5); float w = W[(size_t)(k0 + kk) * N + n0 + (lane & 31)]; if (gain) w *= gain[k0 + kk]; scr[kk * 33 + (lane & 31)] = w; }
    asm volatile("s_waitcnt lgkmcnt(0)" ::: "memory");
    int drow0;
    if (mode == 0) drow0 = row_off + n0; else { const int half = n0 >= Hn ? 1 : 0, c = n0 - half * Hn; drow0 = (c >> 7) * 256 + half * 128 + (c & 127); }
    const int c8 = lane & 7;
#pragma unroll
    for (int j = 0; j < 4; ++j) { const int n = (lane >> 3) + 8 * j; const LAS float* s = scr + (8 * c8) * 33 + n;
        u32x4 o; o.x = cvtpk(s[0 * 33], s[1 * 33]); o.y = cvtpk(s[2 * 33], s[3 * 33]); o.z = cvtpk(s[4 * 33], s[5 * 33]); o.w = cvtpk(s[6 * 33], s[7 * 33]);
        *(u32x4*)(WT + (size_t)(drow0 + n) * K + k0 + 8 * c8) = o; }
    asm volatile("s_waitcnt lgkmcnt(0)" ::: "memory");
}
__device__ __forceinline__ void p0_item64(const float* W, int K, int N, const float* gain, bf16_t* WT, int item, int mode, int Hn, int row_off, LAS float* scr, int lane) {
    const int nkb = K / 64, nb = item / nkb, kb = item - nb * nkb, k0 = 64 * kb, n0 = 64 * nb;
    const int lr = lane >> 4, lc = 4 * (lane & 15);
    f32x4 v[16];
#pragma unroll
    for (int i = 0; i < 16; ++i) v[i] = *(const f32x4*)(W + (size_t)(k0 + 4 * i + lr) * N + n0 + lc);
#pragma unroll
    for (int i = 0; i < 16; ++i) { const int k = 4 * i + lr; f32x4 w = v[i]; if (gain) w = w * gain[k0 + k]; *(LAS f32x4*)(scr + k * 64 + (lc ^ (8 * (k >> 3)))) = w; }
    int drow0;
    if (mode == 0) drow0 = row_off + n0; else { const int half = n0 >= Hn ? 1 : 0, c = n0 - half * Hn; drow0 = (c >> 7) * 256 + half * 128 + (c & 127); }
    const int c8 = lane & 7;
#pragma unroll
    for (int j = 0; j < 8; ++j) { const int n = (lane >> 3) + 8 * j; const LAS float* sp = scr + (8 * c8) * 64 + (n ^ (8 * c8));
        u32x4 o; o.x = cvtpk(sp[0 * 64], sp[1 * 64]); o.y = cvtpk(sp[2 * 64], sp[3 * 64]); o.z = cvtpk(sp[4 * 64], sp[5 * 64]); o.w = cvtpk(sp[6 * 64], sp[7 * 64]);
        *(u32x4*)(WT + (size_t)(drow0 + n) * K + k0 + 8 * c8) = o; }
    asm volatile("s_waitcnt lgkmcnt(0)" ::: "memory");
}
__device__ __forceinline__ void norm_row(const float* xrow, const float* gain, bf16_t* orow, int lane) {
    const f32x4* xr = (const f32x4*)xrow + lane;
    f32x4 v[8]; float s = 0.f;
#pragma unroll
    for (int j = 0; j < 8; ++j) { v[j] = xr[64 * j]; s += (v[j].x * v[j].x + v[j].y * v[j].y) + (v[j].z * v[j].z + v[j].w * v[j].w); }
    const float rstd = 1.0f / sqrtf(wave_sum(s) * (1.f / DM) + EPS);
    u32x2* o8 = (u32x2*)orow + lane;
#pragma unroll
    for (int j = 0; j < 8; ++j) { f32x4 g = {1.f, 1.f, 1.f, 1.f}; if (gain) g = ((const f32x4*)gain)[lane + 64 * j];
        u32x2 w; w.x = cvtpk(v[j].x * rstd * g.x, v[j].y * rstd * g.y); w.y = cvtpk(v[j].z * rstd * g.z, v[j].w * rstd * g.w); o8[64 * j] = w; }
}

__device__ __forceinline__ void sincos_acc(float x, float& sn, float& cs) {
    const double xd = (double)x; const double qd = __builtin_rint(xd * 0.63661977236758134308); const float r = (float)(xd - qd * 1.57079632679489661923);
    const int q = ((int)qd) & 3; const float r2 = r * r;
    const float s = r + r * r2 * (-1.6666667e-1f + r2 * (8.3333333e-3f + r2 * (-1.9841270e-4f + r2 * 2.7557319e-6f)));
    const float c = 1.0f + r2 * (-0.5f + r2 * (4.1666667e-2f + r2 * (-1.3888889e-3f + r2 * (2.4801587e-5f + r2 * -2.7557319e-7f))));
    sn = (q == 0) ? s : (q == 1) ? c : (q == 2) ? -s : -c;
    cs = (q == 0) ? c : (q == 1) ? -s : (q == 2) ? -c : s;
}
__device__ __forceinline__ float gelu_tanh(float y) { const float z = 0.7978845608028654f * (y + 0.044715f * y * y * y); return y * __builtin_amdgcn_rcpf(1.0f + __builtin_amdgcn_exp2f(-2.8853900817779268f * z)); }

template <bool OUT> __device__ __forceinline__ void s5_task(const Args& a, int g, int c, LAS unsigned char* wl, int lane) {
    const int n = lane & 31, hh = lane >> 5;
    const float* a_re = a.in[3]; const float* a_im = a.in[4]; const float* log_dt = a.in[5]; const float* b_re = a.in[6]; const float* b_im = a.in[7];
    const float* c_re = a.in[8]; const float* c_im = a.in[9]; const float* dskip = a.in[10];
    const bf16_t* U = (const bf16_t*)(a.ws + WS_U); bf16_t* G = (bf16_t*)(a.ws + WS_XN); float* SST = (float*)(a.ws + WS_SST);
    float lbr[2], lbi[2]; bf16x8 bfr[4];
    const float dt = expf(log_dt[g]);
#pragma unroll
    for (int s = 0; s < 2; ++s) { const int p = n + 32 * s;
        const float lre = fminf(a_re[g * SP + p], -1e-4f), lim = a_im[g * SP + p];
        const float mag = expf(lre * dt); float sn, cs; sincos_acc(lim * dt, sn, cs);
        lbr[s] = mag * cs; lbi[s] = mag * sn;
        const float den = lre * lre + lim * lim, nr = lbr[s] - 1.0f, ni = lbi[s];
        const float cre = (nr * lre + ni * lim) / den, cim = (ni * lre - nr * lim) / den;
        const f32x4* pbr = (const f32x4*)(b_re + (size_t)(g * SP + p) * SH + 8 * hh); const f32x4* pbi = (const f32x4*)(b_im + (size_t)(g * SP + p) * SH + 8 * hh);
        const f32x4 br0 = pbr[0], br1 = pbr[1], bi0 = pbi[0], bi1 = pbi[1];
        float bre[8], bim[8];
#pragma unroll
        for (int i = 0; i < 4; ++i) { bre[i] = cre * br0[i] - cim * bi0[i]; bim[i] = cre * bi0[i] + cim * br0[i]; bre[4 + i] = cre * br1[i] - cim * bi1[i]; bim[4 + i] = cre * bi1[i] + cim * br1[i]; }
        u32x4 w; w.x = cvtpk(bre[0], bre[1]); w.y = cvtpk(bre[2], bre[3]); w.z = cvtpk(bre[4], bre[5]); w.w = cvtpk(bre[6], bre[7]); bfr[s] = __builtin_bit_cast(bf16x8, w);
        w.x = cvtpk(bim[0], bim[1]); w.y = cvtpk(bim[2], bim[3]); w.z = cvtpk(bim[4], bim[5]); w.w = cvtpk(bim[6], bim[7]); bfr[2 + s] = __builtin_bit_cast(bf16x8, w);
    }
    float hre[2] = {0.f, 0.f}, him[2] = {0.f, 0.f};
    bf16x8 cfr[4]; f32x4 dsk = {0.f, 0.f, 0.f, 0.f};
    if (OUT) {
        const int ho = lane & 15, q4 = lane >> 4;
#pragma unroll
        for (int kk = 0; kk < 4; ++kk) { float v[8];
#pragma unroll
            for (int i = 0; i < 8; ++i) { const int nn = 8 * kk + 2 * q4 + (i >> 2), sel = i & 3; const int p = nn + ((sel & 1) ? 32 : 0);
                v[i] = (sel < 2) ? c_re[(size_t)(g * SH + ho) * SP + p] : -c_im[(size_t)(g * SH + ho) * SP + p]; }
            u32x4 w; w.x = cvtpk(v[0], v[1]); w.y = cvtpk(v[2], v[3]); w.z = cvtpk(v[4], v[5]); w.w = cvtpk(v[6], v[7]); cfr[kk] = __builtin_bit_cast(bf16x8, w); }
        dsk = *(const f32x4*)(dskip + g * SH + 4 * q4);
        float pr[2], pi[2];
#pragma unroll
        for (int s = 0; s < 2; ++s) { pr[s] = lbr[s]; pi[s] = lbi[s];
#pragma unroll
            for (int k = 0; k < 8; ++k) { const float nr2 = pr[s] * pr[s] - pi[s] * pi[s], ni2 = 2.0f * pr[s] * pi[s]; pr[s] = nr2; pi[s] = ni2; } }
        const float* sp = SST + ((size_t)(hh * SG + g) * SP + n) * 2;
#pragma unroll 4
        for (int cc = 0; cc < c; ++cc) { const f32x2_t s0 = *(const f32x2_t*)(sp + (size_t)cc * (2 * SG * SP * 2)); const f32x2_t s1 = *(const f32x2_t*)(sp + (size_t)cc * (2 * SG * SP * 2) + 64);
            float t0 = pr[0] * hre[0] - pi[0] * him[0] + s0.x, t1 = pr[0] * him[0] + pi[0] * hre[0] + s0.y; hre[0] = t0; him[0] = t1;
            t0 = pr[1] * hre[1] - pi[1] * him[1] + s1.x; t1 = pr[1] * him[1] + pi[1] * hre[1] + s1.y; hre[1] = t0; him[1] = t1; }
    }
    const bf16_t* up = U + ((size_t)(((n >> 2) & 1) * SEQ + c * SCH + (n & 3) + 4 * (n >> 3)) * DM + g * SH + 8 * hh);
    bf16x8 afr = *(const bf16x8*)up;
    const f32x16 z16 = {0.f, 0.f, 0.f, 0.f, 0.f, 0.f, 0.f, 0.f, 0.f, 0.f, 0.f, 0.f, 0.f, 0.f, 0.f, 0.f};
    for (int st = 0; st < SCH / 16; ++st) {
        const bf16x8 acur = afr;
        if (st + 1 < SCH / 16) afr = *(const bf16x8*)(up + (size_t)(st + 1) * 16 * DM);
        f32x16 D0 = __builtin_amdgcn_mfma_f32_32x32x16_bf16(acur, bfr[0], z16, 0, 0, 0);
        f32x16 D1 = __builtin_amdgcn_mfma_f32_32x32x16_bf16(acur, bfr[1], z16, 0, 0, 0);
        f32x16 D2 = __builtin_amdgcn_mfma_f32_32x32x16_bf16(acur, bfr[2], z16, 0, 0, 0);
        f32x16 D3 = __builtin_amdgcn_mfma_f32_32x32x16_bf16(acur, bfr[3], z16, 0, 0, 0);
#pragma unroll
        for (int r = 0; r < 16; ++r) {
            float t0 = fmaf(lbr[0], hre[0], fmaf(-lbi[0], him[0], D0[r])), t1 = fmaf(lbr[0], him[0], fmaf(lbi[0], hre[0], D2[r])); hre[0] = t0; him[0] = t1;
            t0 = fmaf(lbr[1], hre[1], fmaf(-lbi[1], him[1], D1[r])); t1 = fmaf(lbr[1], him[1], fmaf(lbi[1], hre[1], D3[r])); hre[1] = t0; him[1] = t1;
            if (OUT) { u32x2 w; w.x = cvtpk(hre[0], hre[1]); w.y = cvtpk(him[0], him[1]); *(LAS u32x2*)(wl + (hh * 16 + r) * 320 + 8 * n) = w; }
        }
        if (OUT) {
            const int tk = lane & 15, q4 = lane >> 4;
#pragma unroll
            for (int tt = 0; tt < 2; ++tt) {
                f32x4 y = {0.f, 0.f, 0.f, 0.f};
#pragma unroll
                for (int kk = 0; kk < 4; ++kk) { const bf16x8 hb = *(const LAS bf16x8*)(wl + (tt * 16 + tk) * 320 + (32 * kk + 8 * q4) * 2); y = __builtin_amdgcn_mfma_f32_16x16x32_bf16(cfr[kk], hb, y, 0, 0, 0); }
                const size_t idx = (size_t)(tt * SEQ + c * SCH + st * 16 + tk) * DM + g * SH + 4 * q4;
                const u32x2 uu = *(const u32x2*)(U + idx);
                const float y0 = y[0] + dsk[0] * bf_lo(uu.x), y1 = y[1] + dsk[1] * bf_hi(uu.x), y2 = y[2] + dsk[2] * bf_lo(uu.y), y3 = y[3] + dsk[3] * bf_hi(uu.y);
                u32x2 w; w.x = cvtpk(gelu_tanh(y0), gelu_tanh(y1)); w.y = cvtpk(gelu_tanh(y2), gelu_tanh(y3)); *(u32x2*)(G + idx) = w;
            }
        }
    }
    if (!OUT) {
        float* sp = SST + ((size_t)((c * 2 + hh) * SG + g) * SP + n) * 2;
        *(f32x2_t*)sp = (f32x2_t){hre[0], him[0]}; *(f32x2_t*)(sp + 64) = (f32x2_t){hre[1], him[1]};
    }
}

__device__ __forceinline__ unsigned off_b(unsigned row, unsigned ch) { return 256u * row + 16u * (ch ^ (((row & 3) << 2) | ((row >> 2) & 3))); }
typedef short v4i16_t __attribute__((ext_vector_type(4)));
__device__ __forceinline__ s16x4 vtr(const LAS unsigned char* p) { return __builtin_bit_cast(s16x4, __builtin_amdgcn_ds_read_tr16_b64_v4i16((LAS v4i16_t*)p)); }

__device__ __forceinline__ void att_glds16(const void* gsrc, unsigned lds_dst) { unsigned keep;
    asm volatile("s_mov_b32 %0, m0\n\ts_mov_b32 m0, %2\n\ts_nop 0\n\tglobal_load_lds_dwordx4 %1, off\n\ts_mov_b32 m0, %0" : "=&s"(keep) : "v"(gsrc), "s"(lds_dst) : "memory"); }
template <int GRP> __device__ __forceinline__ void attn_q_load(const Args& a, int b, int head, int Ts, int uidx, int lane, u32x4 (&raw)[8]) {
    constexpr int dil = (GRP == 0) ? 1 : (GRP == 1) ? 4 : 16;
    const bf16_t* Qg = (const bf16_t*)(a.ws + (GRP == 0 ? WS_Q0 : GRP == 1 ? WS_Q1 : WS_Q2));
    constexpr int nblk = 64 / dil;
    const int n = lane & 31, h = lane >> 5, r = uidx / nblk, blk = uidx % nblk, tq = Ts + r + dil * (32 * blk + n);
    const bf16_t* qrow = Qg + ((size_t)((b * 16 + head) * SEQ + tq) * HP);
#pragma unroll
    for (int kk = 0; kk < 8; ++kk) raw[kk] = *(const u32x4*)(qrow + 16 * kk + 8 * h);
}
template <int GRP> __device__ __forceinline__ void attn_unit(const Args& a, int b, int head, int Ts, int uidx, int unext, LAS unsigned char* vl, int lane, u32x4 (&raw)[8]) {
    constexpr int dil = (GRP == 0) ? 1 : (GRP == 1) ? 4 : 16;
    constexpr float THR = 40.0f;
    const int n = lane & 31, h = lane >> 5;
    bf16_t* Qg = (bf16_t*)(a.ws + (GRP == 0 ? WS_Q0 : GRP == 1 ? WS_Q1 : WS_Q2));
    const bf16_t* Kb = (const bf16_t*)(a.ws + WS_K); const bf16_t* Vb = (const bf16_t*)(a.ws + WS_V);
    float* LSE = (float*)(a.ws + WS_LSE);
    const float* qn = a.in[16] + GRP * HD;
    constexpr int nblk = 64 / dil;
    const int r = uidx / nblk, blk = uidx % nblk;
    const int tq = Ts + r + dil * (32 * blk + n);
    bf16_t* qrow = Qg + ((size_t)((b * 16 + head) * SEQ + tq) * HP);
    int kt = (5 - blk % 5) % 5;
    const int vrow_l = lane >> 4; const int vch[4] = {(lane & 15) ^ ((vrow_l << 2) | 0), (lane & 15) ^ ((vrow_l << 2) | 1), (lane & 15) ^ ((vrow_l << 2) | 2), (lane & 15) ^ ((vrow_l << 2) | 3)};
    const bf16_t* vbase = Vb + ((size_t)(b * 16 + head) * SEQ * HP);
    const unsigned vlds0 = (unsigned)(uintptr_t)vl;
    const bf16_t* kbase = Kb + ((size_t)(b * 16 + head) * SEQ * HP);
#define ATT_DMA_T(base_, kt_, buf_) do { const int jb_ = 32 * blk - 128 + 32 * (kt_); _Pragma("unroll") for (int i_ = 0; i_ < 8; ++i_) { int tk_ = Ts + r + dil * (jb_ + 4 * i_ + vrow_l); tk_ = tk_ < 0 ? 0 : tk_; \
        att_glds16((base_) + (size_t)tk_ * HP + 8 * vch[i_ & 3], (unsigned)__builtin_amdgcn_readfirstlane((int)(vlds0 + (buf_) * 8192 + i_ * 1024))); } } while (0)
    asm volatile("" ::: "memory");
    ATT_DMA_T(kbase, kt, 0);
    ATT_DMA_T(vbase, kt, 1);
    asm volatile("" ::: "memory");
    const unsigned kx = ((n & 3) << 2) | ((n >> 2) & 3);
    bf16x8 qf[8];
    {
        float ss = 0.f;
#pragma unroll
        for (int kk = 0; kk < 8; ++kk)
#pragma unroll
            for (int e = 0; e < 4; ++e) { const float lo = bf_lo(raw[kk][e]), hi = bf_hi(raw[kk][e]); ss += lo * lo + hi * hi; }
        ss += __shfl_xor(ss, 32);
        const float sc = (1.0f / sqrtf(ss * (1.f / HD) + EPS)) * 0.08838834764831845f * 1.4426950408889634f;
#pragma unroll
        for (int kk = 0; kk < 8; ++kk) { const f32x4 g0 = *(const f32x4*)(qn + 16 * kk + 8 * h), g1 = *(const f32x4*)(qn + 16 * kk + 8 * h + 4); u32x4 w;
            w.x = cvtpk(bf_lo(raw[kk].x) * sc * g0.x, bf_hi(raw[kk].x) * sc * g0.y); w.y = cvtpk(bf_lo(raw[kk].y) * sc * g0.z, bf_hi(raw[kk].y) * sc * g0.w);
            w.z = cvtpk(bf_lo(raw[kk].z) * sc * g1.x, bf_hi(raw[kk].z) * sc * g1.y); w.w = cvtpk(bf_lo(raw[kk].w) * sc * g1.z, bf_hi(raw[kk].w) * sc * g1.w);
            qf[kk] = __builtin_bit_cast(bf16x8, w); }
    }
    const float slope2 = exp2f(-8.0f * (float)(3 * head + GRP + 1) / 48.0f) * (float)dil * 1.4426950408889634f;
    float m = 0.f, l = 0.f;
    const f32x16 z16 = {0.f, 0.f, 0.f, 0.f, 0.f, 0.f, 0.f, 0.f, 0.f, 0.f, 0.f, 0.f, 0.f, 0.f, 0.f, 0.f};
    f32x16 O[4] = {z16, z16, z16, z16};
    unsigned tro[2][2], cbo[4];
    { const unsigned blk2 = (lane >> 4) & 1, q = (lane & 15) >> 2, p = lane & 3;
#pragma unroll
      for (int s = 0; s < 2; ++s)
#pragma unroll
        for (int t = 0; t < 2; ++t) { const unsigned row = 16 * s + 4 * h + 8 * t + q; tro[s][t] = 256u * row + 16u * ((2 * blk2 + (p >> 1)) ^ ((row >> 2) & 3)) + 8 * (p & 1); }
#pragma unroll
      for (int cb = 0; cb < 4; ++cb) cbo[cb] = 64u * ((unsigned)cb ^ q); }
#pragma unroll 1
    for (int st = 0; st < 5; ++st) {
        const bool has_next = st < 4; const int ktn = (kt == 4) ? 0 : kt + 1;
        const int jbase = 32 * blk - 128 + 32 * kt;
        const float lb = -slope2 * (float)(128 - 32 * kt + n - 4 * h) - m;
        f32x16 S;
#pragma unroll
        for (int rr = 0; rr < 16; ++rr) S[rr] = fmaf(slope2, (float)((rr & 3) + 8 * (rr >> 2)), lb);
        asm volatile("s_waitcnt vmcnt(8)" ::: "memory");
        bf16x8 kf[8];
#pragma unroll
        for (int kk = 0; kk < 8; ++kk) kf[kk] = *(const LAS bf16x8*)(vl + 256 * n + 16 * ((unsigned)(2 * kk + h) ^ kx));
#pragma unroll
        for (int kk = 0; kk < 8; ++kk) S = __builtin_amdgcn_mfma_f32_32x32x16_bf16(kf[kk], qf[kk], S, 0, 0, 0);
        asm volatile("s_waitcnt lgkmcnt(0)" ::: "memory");
        if (has_next) ATT_DMA_T(kbase, ktn, 0);
        asm volatile("" ::: "memory");
        if (kt == 0 || kt == 4 || Ts + r + dil * jbase < 0) {
#pragma unroll
            for (int rr = 0; rr < 16; ++rr) { const int j = crow(rr, h); const int dist = 128 - 32 * kt + n - j; const bool ok = (dist >= 0) && (dist <= 128) && (Ts + r + dil * (jbase + j) >= 0);
                S[rr] = ok ? S[rr] : -INFINITY; }
        }
        float tmax = fmaxf(fmaxf(S[0], S[1]), fmaxf(S[2], S[3]));
#pragma unroll
        for (int rr = 4; rr < 16; rr += 4) tmax = fmaxf(tmax, fmaxf(fmaxf(S[rr], S[rr + 1]), fmaxf(S[rr + 2], S[rr + 3])));
        tmax = fmaxf(tmax, __shfl_xor(tmax, 32));
        if (__builtin_expect(__any(tmax > THR), 0)) {
            const float dl = tmax > THR ? tmax : 0.f; const float f = __builtin_amdgcn_exp2f(-dl); m += dl; l *= f;
#pragma unroll
            for (int rr = 0; rr < 16; ++rr) S[rr] -= dl;
#pragma unroll
            for (int cb = 0; cb < 4; ++cb)
#pragma unroll
                for (int rr = 0; rr < 16; ++rr) O[cb][rr] *= f;
        }
        float ps = 0.f;
#pragma unroll
        for (int rr = 0; rr < 16; ++rr) { const float p = __builtin_amdgcn_exp2f(S[rr]); S[rr] = p; ps += p; }
        l += ps;
        bf16x8 pf[2];
#pragma unroll
        for (int s = 0; s < 2; ++s) { u32x4 w; w.x = cvtpk(S[8 * s + 0], S[8 * s + 1]); w.y = cvtpk(S[8 * s + 2], S[8 * s + 3]); w.z = cvtpk(S[8 * s + 4], S[8 * s + 5]); w.w = cvtpk(S[8 * s + 6], S[8 * s + 7]); pf[s] = __builtin_bit_cast(bf16x8, w); }
        if (has_next) asm volatile("s_waitcnt vmcnt(8)" ::: "memory"); else asm volatile("s_waitcnt vmcnt(0)" ::: "memory");
        const LAS unsigned char* vb = vl + 8192;
#pragma unroll
        for (int cb = 0; cb < 4; ++cb)
#pragma unroll
            for (int s = 0; s < 2; ++s) { const s16x4 lo = vtr(vb + tro[s][0] + cbo[cb]), hi = vtr(vb + tro[s][1] + cbo[cb]);
                const bf16x8 vf = {lo[0], lo[1], lo[2], lo[3], hi[0], hi[1], hi[2], hi[3]};
                O[cb] = __builtin_amdgcn_mfma_f32_32x32x16_bf16(vf, pf[s], O[cb], 0, 0, 0); }
        asm volatile("s_waitcnt lgkmcnt(0)" ::: "memory");
        if (has_next) ATT_DMA_T(vbase, ktn, 1);
        asm volatile("" ::: "memory");
        __builtin_amdgcn_s_barrier();
        kt = ktn;
    }
#undef ATT_DMA_T
    const float lt = l + __shfl_xor(l, 32);
    const float lse2 = m + __builtin_amdgcn_logf(lt);
    float w0 = 1.0f / lt, w1 = 0.f, w2 = 0.f;
    const size_t hrow = (size_t)(b * 16 + head) * SEQ + tq;
    if (GRP != 0) { if (h == 0) LSE[(size_t)(GRP - 1) * MTOK * NHEAD + hrow] = lse2; }
    else { const float l1 = LSE[hrow], l2 = LSE[(size_t)MTOK * NHEAD + hrow];
        const float mx = fmaxf(lse2, fmaxf(l1, l2)); const float e0 = __builtin_amdgcn_exp2f(lse2 - mx), e1 = __builtin_amdgcn_exp2f(l1 - mx), e2 = __builtin_amdgcn_exp2f(l2 - mx);
        const float inv = 1.0f / (e0 + e1 + e2); w0 = e0 * inv / lt; w1 = e1 * inv; w2 = e2 * inv; }
    const bf16_t* o1row = (const bf16_t*)(a.ws + WS_Q1) + hrow * HP; const bf16_t* o2row = (const bf16_t*)(a.ws + WS_Q2) + hrow * HP;
    bf16_t* orow = (GRP == 0) ? (bf16_t*)a.out + ((size_t)(b * SEQ + tq) * DM + head * HD) : qrow;
#pragma unroll
    for (int cb = 0; cb < 4; ++cb)
#pragma unroll
        for (int rg = 0; rg < 4; ++rg) { const int d0 = 32 * cb + 8 * rg + 4 * h;
            float o0 = O[cb][4 * rg + 0] * w0, o1 = O[cb][4 * rg + 1] * w0, o2 = O[cb][4 * rg + 2] * w0, o3 = O[cb][4 * rg + 3] * w0;
            if (GRP == 0) { const u32x2 x1 = *(const u32x2*)(o1row + d0), x2 = *(const u32x2*)(o2row + d0);
                o0 += w1 * bf_lo(x1.x) + w2 * bf_lo(x2.x); o1 += w1 * bf_hi(x1.x) + w2 * bf_hi(x2.x); o2 += w1 * bf_lo(x1.y) + w2 * bf_lo(x2.y); o3 += w1 * bf_hi(x1.y) + w2 * bf_hi(x2.y); }
            u32x2 w; w.x = cvtpk(o0, o1); w.y = cvtpk(o2, o3); *(u32x2*)(orow + d0) = w; }
}
template <int GRP> __device__ __forceinline__ void attn_stage(const Args& a, int b, int head, int Ts, int wave, LAS unsigned char* vl, int lane) {
    asm volatile("" : "+v"(lane));
    u32x4 raw[8];
    for (int u = wave; u < 64; u += NWAVES) { attn_q_load<GRP>(a, b, head, Ts, u, lane, raw); attn_unit<GRP>(a, b, head, Ts, u, (u + NWAVES < 64) ? u + NWAVES : -1, vl, lane, raw); }
}


struct AttStep { int dil, grp, rd, s, B0, nbr; };
__device__ __forceinline__ AttStep att_decode(int S) { AttStep t; const int st = S / 40; t.rd = (S % 40) / 5; t.s = S % 5; t.dil = st == 0 ? 16 : st == 1 ? 4 : 1; t.grp = 2 - st;
    t.B0 = (t.dil == 16) ? 0 : (t.dil == 4 ? (t.rd & 1) * 8 : t.rd * 8); t.nbr = (t.dil == 16) ? 4 : 8; return t; }
__device__ __forceinline__ int att_res(const AttStep& t, int group) { return (t.dil == 16) ? 2 * t.rd + group : (t.dil == 4 ? (t.rd >> 1) : 0); }
__device__ __forceinline__ int att_tmin(const AttStep& t) { return t.B0 + ((t.s - t.B0 % 5 + 5) % 5); }
__device__ __forceinline__ void attn_shared(const Args& a, int b, int head, int Ts, int wave, LAS unsigned char* lds, int lane) {
    asm volatile("" : "+v"(lane));
    int hp = HP; asm volatile("" : "+s"(hp));
    LAS float* gl = (LAS float*)(lds + 131072 + 1024);
    { const int tix = wave * 64 + lane; if (tix < 3 * HD) gl[tix] = a.in[16][tix]; }
    asm volatile("" ::: "memory");
    constexpr float THR = 40.0f;
    const int n = lane & 31, h = lane >> 5;
    const bf16_t* kbase = (const bf16_t*)(a.ws + WS_K) + ((size_t)(b * 16 + head) * SEQ * hp);
    const bf16_t* vbase = (const bf16_t*)(a.ws + WS_V) + ((size_t)(b * 16 + head) * SEQ * hp);
    float* LSE = (float*)(a.ws + WS_LSE);
    const unsigned lds0 = (unsigned)(uintptr_t)lds;
    const int vrow_l = lane >> 4;
    const unsigned kx = ((n & 3) << 2) | ((n >> 2) & 3);
    unsigned tro[2][2], q64;
    { const unsigned blk2 = (lane >> 4) & 1, q = (lane & 15) >> 2, p = lane & 3;
#pragma unroll
      for (int s = 0; s < 2; ++s)
#pragma unroll
        for (int t = 0; t < 2; ++t) { const unsigned row = 16 * s + 4 * h + 8 * t + q; tro[s][t] = 256u * row + 16u * ((2 * blk2 + (p >> 1)) ^ ((row >> 2) & 3)) + 8 * (p & 1); }
      q64 = 64u * q; }
#define ATT_ISSUE(Sx_) do { const AttStep t_ = att_decode(Sx_); const int tmin_ = att_tmin(t_); \
        _Pragma("unroll") for (int slot_ = 0; slot_ < 4; ++slot_) { const int gi_ = (t_.dil == 16) ? (slot_ >> 1) : 0, idx_ = (t_.dil == 16) ? (slot_ & 1) : slot_; const int T_ = tmin_ + 5 * idx_; \
            if (T_ <= t_.B0 + t_.nbr + 3 && (t_.dil == 16 || slot_ < 3)) { int tk_ = Ts + att_res(t_, gi_) + t_.dil * (32 * (T_ - 4) + 4 * wave + vrow_l); tk_ = tk_ < 0 ? 0 : tk_; \
                const size_t go_ = (size_t)tk_ * hp + 8 * ((lane & 15) ^ ((vrow_l << 2) | (wave & 3))); const unsigned ld_ = lds0 + (((Sx_) & 1) * 65536 + slot_ * 16384 + wave * 1024); \
                att_glds16(kbase + go_, (unsigned)__builtin_amdgcn_readfirstlane((int)ld_)); att_glds16(vbase + go_, (unsigned)__builtin_amdgcn_readfirstlane((int)(ld_ + 8192))); } } } while (0)
#define ATT_QROW(t_, grp_) ((bf16_t*)(a.ws + ((grp_) == 0 ? WS_Q0 : (grp_) == 1 ? WS_Q1 : WS_Q2)) + ((size_t)((b * 16 + head) * SEQ + Ts + att_res(t_, (t_.dil == 16) ? (wave >> 2) : 0) + t_.dil * (32 * (t_.B0 + ((t_.dil == 16) ? (wave & 3) : wave)) + n)) * hp))
    u32x4 raw[8];
    { const AttStep t0 = att_decode(0); const bf16_t* qr = ATT_QROW(t0, t0.grp);
#pragma unroll
      for (int kk = 0; kk < 8; ++kk) raw[kk] = *(const u32x4*)(qr + 16 * kk + 8 * h); }
    asm volatile("" ::: "memory");
    ATT_ISSUE(0);
    asm volatile("s_waitcnt vmcnt(0) lgkmcnt(0)" ::: "memory"); __builtin_amdgcn_s_barrier(); asm volatile("" ::: "memory");
    bf16x8 qf[8]; float slope2 = 0.f, m = 0.f, l = 0.f;
    const f32x16 z16 = {0.f, 0.f, 0.f, 0.f, 0.f, 0.f, 0.f, 0.f, 0.f, 0.f, 0.f, 0.f, 0.f, 0.f, 0.f, 0.f};
    f32x16 O[4] = {z16, z16, z16, z16};
#pragma unroll 1
    for (int S = 0; S < 120; ++S) {
        const AttStep t = att_decode(S);
        asm volatile("" ::: "memory");
        if (S + 1 < 120) ATT_ISSUE(S + 1);
        asm volatile("" ::: "memory");
        const int group = (t.dil == 16) ? (wave >> 2) : 0, B = t.B0 + ((t.dil == 16) ? (wave & 3) : wave), r = att_res(t, group);
        if (t.s == 4 && S + 1 < 120) {
            const AttStep tn = att_decode(S + 1); const bf16_t* qr = ATT_QROW(tn, tn.grp);
#pragma unroll
            for (int kk = 0; kk < 8; ++kk) raw[kk] = *(const u32x4*)(qr + 16 * kk + 8 * h); }
        if (t.s == 0) {
            const LAS float* qn = gl + t.grp * HD; float ss = 0.f;
#pragma unroll
            for (int kk = 0; kk < 8; ++kk)
#pragma unroll
                for (int e = 0; e < 4; ++e) { const float lo = bf_lo(raw[kk][e]), hi = bf_hi(raw[kk][e]); ss += lo * lo + hi * hi; }
            ss += __shfl_xor(ss, 32);
            const float sc = (1.0f / sqrtf(ss * (1.f / HD) + EPS)) * 0.08838834764831845f * 1.4426950408889634f;
#pragma unroll
            for (int kk = 0; kk < 8; ++kk) { const f32x4 g0 = *(const LAS f32x4*)(qn + 16 * kk + 8 * h), g1 = *(const LAS f32x4*)(qn + 16 * kk + 8 * h + 4); u32x4 w;
                w.x = cvtpk(bf_lo(raw[kk].x) * sc * g0.x, bf_hi(raw[kk].x) * sc * g0.y); w.y = cvtpk(bf_lo(raw[kk].y) * sc * g0.z, bf_hi(raw[kk].y) * sc * g0.w);
                w.z = cvtpk(bf_lo(raw[kk].z) * sc * g1.x, bf_hi(raw[kk].z) * sc * g1.y); w.w = cvtpk(bf_lo(raw[kk].w) * sc * g1.z, bf_hi(raw[kk].w) * sc * g1.w);
                qf[kk] = __builtin_bit_cast(bf16x8, w); }
            slope2 = exp2f(-8.0f * (float)(3 * head + t.grp + 1) / 48.0f) * (float)t.dil * 1.4426950408889634f;
            m = 0.f; l = 0.f;
#pragma unroll
            for (int cb = 0; cb < 4; ++cb) O[cb] = z16;
        }
        const int kt = (t.s - B % 5 + 5) % 5, T = B + kt, slot = ((t.dil == 16) ? 2 * group : 0) + (T - att_tmin(t)) / 5;
        const LAS unsigned char* kl = lds + ((S & 1) * 65536 + slot * 16384);
        const int jbase = 32 * (T - 4);
        const float lb = -slope2 * (float)(128 - 32 * kt + n - 4 * h) - m;
        f32x16 Sc;
#pragma unroll
        for (int rr = 0; rr < 16; ++rr) Sc[rr] = fmaf(slope2, (float)((rr & 3) + 8 * (rr >> 2)), lb);
        { bf16x8 kf[8];
#pragma unroll
          for (int kk = 0; kk < 8; ++kk) kf[kk] = *(const LAS bf16x8*)(kl + 256 * n + 16 * ((unsigned)(2 * kk + h) ^ kx));
          __builtin_amdgcn_s_setprio(1);
#pragma unroll
          for (int kk = 0; kk < 8; ++kk) Sc = __builtin_amdgcn_mfma_f32_32x32x16_bf16(kf[kk], qf[kk], Sc, 0, 0, 0);
          __builtin_amdgcn_s_setprio(0); }
        if (Ts + r + t.dil * jbase < 0) {
#pragma unroll
            for (int rr = 0; rr < 16; ++rr) { const int j = crow(rr, h); const int dist = 128 - 32 * kt + n - j; const bool ok = (dist >= 0) && (dist <= 128) && (Ts + r + t.dil * (jbase + j) >= 0);
                Sc[rr] = ok ? Sc[rr] : -INFINITY; }
        } else if (kt == 0) {
#pragma unroll
            for (int rr = 0; rr < 16; ++rr) Sc[rr] = (crow(rr, h) >= n) ? Sc[rr] : -INFINITY;
        } else if (kt == 4) {
#pragma unroll
            for (int rr = 0; rr < 16; ++rr) Sc[rr] = (crow(rr, h) <= n) ? Sc[rr] : -INFINITY;
        }
        float tmax = fmaxf(fmaxf(Sc[0], Sc[1]), fmaxf(Sc[2], Sc[3]));
#pragma unroll
        for (int rr = 4; rr < 16; rr += 4) tmax = fmaxf(tmax, fmaxf(fmaxf(Sc[rr], Sc[rr + 1]), fmaxf(Sc[rr + 2], Sc[rr + 3])));
        if (__builtin_expect(__any(tmax > THR), 0)) {
            tmax = fmaxf(tmax, __shfl_xor(tmax, 32));
            const float dl = tmax > THR ? tmax : 0.f; const float f = __builtin_amdgcn_exp2f(-dl); m += dl; l *= f;
#pragma unroll
            for (int rr = 0; rr < 16; ++rr) Sc[rr] -= dl;
#pragma unroll
            for (int cb = 0; cb < 4; ++cb)
#pragma unroll
                for (int rr = 0; rr < 16; ++rr) O[cb][rr] *= f;
        }
        float ps = 0.f;
#pragma unroll
        for (int rr = 0; rr < 16; ++rr) { const float p = __builtin_amdgcn_exp2f(Sc[rr]); Sc[rr] = p; ps += p; }
        l += ps;
        bf16x8 pf[2];
#pragma unroll
        for (int s2 = 0; s2 < 2; ++s2) { u32x4 w; w.x = cvtpk(Sc[8 * s2 + 0], Sc[8 * s2 + 1]); w.y = cvtpk(Sc[8 * s2 + 2], Sc[8 * s2 + 3]); w.z = cvtpk(Sc[8 * s2 + 4], Sc[8 * s2 + 5]); w.w = cvtpk(Sc[8 * s2 + 6], Sc[8 * s2 + 7]); pf[s2] = __builtin_bit_cast(bf16x8, w); }
        { const LAS unsigned char* vb = kl + 8192;
#pragma unroll
          for (int cb = 0; cb < 4; ++cb)
#pragma unroll
            for (int s2 = 0; s2 < 2; ++s2) { const unsigned co = (64u * cb) ^ q64; const s16x4 lo = vtr(vb + tro[s2][0] + co), hi = vtr(vb + tro[s2][1] + co);
                const bf16x8 vf = {lo[0], lo[1], lo[2], lo[3], hi[0], hi[1], hi[2], hi[3]};
                __builtin_amdgcn_s_setprio(1); O[cb] = __builtin_amdgcn_mfma_f32_32x32x16_bf16(vf, pf[s2], O[cb], 0, 0, 0); __builtin_amdgcn_s_setprio(0); } }
        if (t.s == 4) {
            const int tq = Ts + r + t.dil * (32 * B + n);
            const float lt = l + __shfl_xor(l, 32);
            const float lse2 = m + __builtin_amdgcn_logf(lt);
            float w0 = 1.0f / lt, w1 = 0.f, w2 = 0.f;
            const size_t hrow = (size_t)(b * 16 + head) * SEQ + tq;
            if (t.grp != 0) { if (h == 0) LSE[(size_t)(t.grp - 1) * MTOK * NHEAD + hrow] = lse2; }
            else { const float l1 = LSE[hrow], l2 = LSE[(size_t)MTOK * NHEAD + hrow];
                const float mx = fmaxf(lse2, fmaxf(l1, l2)); const float e0 = __builtin_amdgcn_exp2f(lse2 - mx), e1 = __builtin_amdgcn_exp2f(l1 - mx), e2 = __builtin_amdgcn_exp2f(l2 - mx);
                const float inv = 1.0f / (e0 + e1 + e2); w0 = e0 * inv / lt; w1 = e1 * inv; w2 = e2 * inv; }
            LAS unsigned char* stg = lds + LDS_STG + wave * STG_WAVE; LAS float* wq = (LAS float*)(stg + 32 * STG_PITCH);
            if (t.grp == 0 && h == 0) { wq[2 * n] = w1; wq[2 * n + 1] = w2; }
            const bf16_t* o1b = (const bf16_t*)(a.ws + WS_Q1); const bf16_t* o2b = (const bf16_t*)(a.ws + WS_Q2);
            bf16_t* ogb = (bf16_t*)(a.ws + (t.grp == 1 ? WS_Q1 : WS_Q2));
#pragma unroll
            for (int cb = 0; cb < 4; ++cb) {
#pragma unroll
                for (int rg = 0; rg < 4; ++rg) { u32x2 w; w.x = cvtpk(O[cb][4 * rg + 0] * w0, O[cb][4 * rg + 1] * w0); w.y = cvtpk(O[cb][4 * rg + 2] * w0, O[cb][4 * rg + 3] * w0);
                    *(LAS u32x2*)(stg + n * STG_PITCH + 16 * rg + 8 * h) = w; }
#pragma unroll
                for (int j = 0; j < 2; ++j) { const int c = lane + 64 * j, row = c >> 2, part = c & 3;
                    const u32x4 v = *(const LAS u32x4*)(stg + row * STG_PITCH + part * 16);
                    const int tqr = Ts + r + t.dil * (32 * B + row); const size_t hr = (size_t)(b * 16 + head) * SEQ + tqr; const int dcol = 32 * cb + 8 * part;
                    if (t.grp == 0) { const u32x4 x1 = *(const u32x4*)(o1b + hr * hp + dcol), x2 = *(const u32x4*)(o2b + hr * hp + dcol); const float a1 = wq[2 * row], a2 = wq[2 * row + 1]; u32x4 o;
                        o.x = cvtpk(bf_lo(v.x) + a1 * bf_lo(x1.x) + a2 * bf_lo(x2.x), bf_hi(v.x) + a1 * bf_hi(x1.x) + a2 * bf_hi(x2.x));
                        o.y = cvtpk(bf_lo(v.y) + a1 * bf_lo(x1.y) + a2 * bf_lo(x2.y), bf_hi(v.y) + a1 * bf_hi(x1.y) + a2 * bf_hi(x2.y));
                        o.z = cvtpk(bf_lo(v.z) + a1 * bf_lo(x1.z) + a2 * bf_lo(x2.z), bf_hi(v.z) + a1 * bf_hi(x1.z) + a2 * bf_hi(x2.z));
                        o.w = cvtpk(bf_lo(v.w) + a1 * bf_lo(x1.w) + a2 * bf_lo(x2.w), bf_hi(v.w) + a1 * bf_hi(x1.w) + a2 * bf_hi(x2.w));
                        *(u32x4*)((bf16_t*)a.out + ((size_t)(b * SEQ + tqr) * DM + head * HD + dcol)) = o; }
                    else *(u32x4*)(ogb + hr * hp + dcol) = v;
                    asm volatile("" ::: "memory"); }
                asm volatile("" ::: "memory");
            }
        }
        if (S == 79) __threadfence();
        if (t.s == 4 && S != 79) asm volatile("s_waitcnt vmcnt(8) lgkmcnt(0)" ::: "memory");
        else asm volatile("s_waitcnt vmcnt(0) lgkmcnt(0)" ::: "memory");
        __builtin_amdgcn_s_barrier(); asm volatile("" ::: "memory");
        if (S == 79) __builtin_amdgcn_fence(__ATOMIC_ACQUIRE, "agent");
    }
#undef ATT_ISSUE
#undef ATT_QROW
}

#define XB_TMO      128
#define XB_XCNT(j)  (256  + 64 * (j))
#define XB_XSUB(j)  (1280 + 64 * (j))
#define XB_XGEN(j)  (2304 + 64 * (j))
#define XB_TOP      3328
#define XB_TOPGEN   3392
#define XCD_BAR_WORDS 3456
#define XB_SPIN_CAP (1u << 18)

__device__ __forceinline__ unsigned xb_ld(unsigned* p)              { return __hip_atomic_load(p, __ATOMIC_RELAXED, __HIP_MEMORY_SCOPE_AGENT); }
__device__ __forceinline__ unsigned xb_add(unsigned* p, unsigned v) { return __hip_atomic_fetch_add(p, v, __ATOMIC_RELAXED, __HIP_MEMORY_SCOPE_AGENT); }
__device__ __forceinline__ unsigned xb_xcc_id() { return (unsigned)__builtin_amdgcn_s_getreg((3 << 11) | 20) & 0xFu; }
#define XB_SPIN(cond, bar) do { unsigned _sp = 0; while (cond) { __builtin_amdgcn_s_sleep(1); \
    if ((++_sp & 255u) == 0u) { if (xb_ld(&(bar)[XB_TMO])) break; if (_sp > XB_SPIN_CAP) { atomicAdd(&(bar)[XB_TMO], 1u); break; } } } } while (0)

struct XcdBarrier {
    unsigned* bar; unsigned x;
    volatile LAS unsigned* st;
};

__device__ __forceinline__ XcdBarrier xcd_barrier_post(unsigned* bar, volatile LAS unsigned* st) {
    XcdBarrier b; b.bar = bar; b.x = xb_xcc_id(); b.st = st;
    if (threadIdx.x == 0) (void)xb_add(&bar[XB_XCNT(b.x)], 1u);
    return b;
}
__device__ __forceinline__ void xcd_barrier_complete(unsigned* bar, unsigned x, unsigned& nloc, unsigned& nx) {
    const unsigned G = gridDim.x * gridDim.y * gridDim.z;
    unsigned sum, cnt, mine, sp = 0u;
    for (;;) {
        sum = 0u; cnt = 0u; mine = 0u;
#pragma unroll
        for (unsigned j = 0; j < 16; ++j) { const unsigned c = xb_ld(&bar[XB_XCNT(j)]); sum += c; cnt += (c > 0u) ? 1u : 0u; mine = (j == x) ? c : mine; }
        if (sum == G) break;
        __builtin_amdgcn_s_sleep(1);
        if ((++sp & 255u) == 0u) { if (xb_ld(&bar[XB_TMO])) break; if (sp > XB_SPIN_CAP) { atomicAdd(&bar[XB_TMO], 1u); break; } }
    }
    nloc = mine > 0u ? mine : 1u; nx = cnt > 0u ? cnt : 1u;
}

__device__ __forceinline__ void xcd_barrier(const XcdBarrier& b) {
    asm volatile("s_waitcnt vmcnt(0)" ::: "memory");
    __syncthreads();
    if (threadIdx.x == 0) {
        unsigned* bar = b.bar;
        __builtin_amdgcn_s_waitcnt(0);
        unsigned nloc = b.st[0], nx = b.st[1];
        if (nloc == 0u) { xcd_barrier_complete(bar, b.x, nloc, nx); b.st[0] = nloc; b.st[1] = nx; }
        const unsigned old = xb_add(&bar[XB_XSUB(b.x)], 1u);
        const unsigned gen = old / nloc;
        if (old + 1u == (gen + 1u) * nloc) {
            __builtin_amdgcn_fence(__ATOMIC_RELEASE, "agent");
            asm volatile("s_waitcnt vmcnt(0)" ::: "memory");
            const unsigned og = xb_add(&bar[XB_TOP], 1u);
            const unsigned tg = og / nx;
            if (og + 1u == (tg + 1u) * nx) xb_add(&bar[XB_TOPGEN], 1u);
            else XB_SPIN(xb_ld(&bar[XB_TOPGEN]) == tg, bar);
            __builtin_amdgcn_fence(__ATOMIC_ACQUIRE, "agent");
            xb_add(&bar[XB_XGEN(b.x)], 1u);
            asm volatile("s_waitcnt vmcnt(0)" ::: "memory");
        } else {
            XB_SPIN(xb_ld(&bar[XB_XGEN(b.x)]) == gen, bar);
            __builtin_amdgcn_fence(__ATOMIC_ACQUIRE, "agent");
            asm volatile("s_waitcnt vmcnt(0)" ::: "memory");
        }
    }
    __syncthreads();
}

__global__ void __launch_bounds__(NWAVES * 64, 2) mega_fwd(Args a) {
    extern __shared__ __attribute__((aligned(16))) unsigned char lds_raw[];
    LAS unsigned char* lds = (LAS unsigned char*)lds_raw;
    cg::grid_group grid = cg::this_grid();
    const int tid = threadIdx.x, lane = tid & 63, wave = __builtin_amdgcn_readfirstlane(tid >> 6);
    const int G = gridDim.x, bx = blockIdx.x;
    const int vcu = (G % 8 == 0) ? (bx % 8) * (G / 8) + bx / 8 : bx;
    const int gw = vcu * NWAVES + wave, NGW = G * NWAVES;
    unsigned char* ws = a.ws;
    const float* x_in = a.in[0]; float* xo = a.out;
    volatile LAS unsigned* MISC = (volatile LAS unsigned*)(lds + 131072 + 320);
    if (tid < 32) MISC[tid] = 0u;
    __syncthreads();
    bf16_t* Wglu = (bf16_t*)(ws + WS_WGLU); bf16_t* Wqkv = (bf16_t*)(ws + WS_WQKV); bf16_t* Wo = (bf16_t*)(ws + WS_WO);
    bf16_t* Wgu0 = (bf16_t*)(ws + WS_WGU0); bf16_t* Wgu1 = (bf16_t*)(ws + WS_WGU1); bf16_t* Wd0 = (bf16_t*)(ws + WS_WD0); bf16_t* Wd1 = (bf16_t*)(ws + WS_WD1);
    bf16_t* X1 = (bf16_t*)a.out;
    float* RS1 = (float*)ws; float* RS2 = RS1 + MTOK; float* RS3 = RS2 + MTOK;
    bf16_t* XN = (bf16_t*)(ws + WS_XN); bf16_t* HB = (bf16_t*)(ws + WS_BIG); bf16_t* Q0 = (bf16_t*)(ws + WS_Q0); bf16_t* KB = (bf16_t*)(ws + WS_K);

    {
        LAS float* scr = (LAS float*)(lds + wave * 16384);
        constexpr int I_GLU = 32 * 64, I_Q = 32 * 96, I_KV = 32 * 64, I_O = 32 * 32, I_GU = 32 * 176, I_D = 88 * 32;
        constexpr int NITEMS = I_GLU + I_Q + I_KV + I_O + 2 * I_GU + 2 * I_D;
        for (int it = gw; it < NITEMS; it += NGW) {
            int r = it;
            if (r < I_GLU) { p0_item64(a.in[11], DM, 2 * DM, nullptr, Wglu, r, 1, DM, 0, scr, lane); continue; } r -= I_GLU;
            if (r < I_Q) { p0_item64(a.in[15], DM, 3 * DM, a.in[1] + DM, Wqkv, r, 0, 0, 0, scr, lane); continue; } r -= I_Q;
            if (r < I_KV) { p0_item64(a.in[13], DM, 2 * DM, a.in[12], Wqkv, r, 0, 0, 3 * DM, scr, lane); continue; } r -= I_KV;
            if (r < I_O) { p0_item64(a.in[17], DM, DM, nullptr, Wo, r, 0, 0, 0, scr, lane); continue; } r -= I_O;
            if (r < I_GU) { p0_item64(a.in[18], DM, 2 * DFF, a.in[2], Wgu0, r, 1, DFF, 0, scr, lane); continue; } r -= I_GU;
            if (r < I_GU) { p0_item64(a.in[18] + (size_t)DM * 2 * DFF, DM, 2 * DFF, a.in[2] + DM, Wgu1, r, 1, DFF, 0, scr, lane); continue; } r -= I_GU;
            if (r < I_D) { p0_item64(a.in[19], DFF, DM, nullptr, Wd0, r, 0, 0, 0, scr, lane); continue; } r -= I_D;
            p0_item64(a.in[19] + (size_t)DFF * DM, DFF, DM, nullptr, Wd1, r, 0, 0, 0, scr, lane);
        }
        for (int i = gw * 64 + lane; i < 3 * MTOK; i += NGW * 64) RS1[i] = 0.f;
        if (bx == 0) for (int i = tid; i < XCD_BAR_WORDS; i += NWAVES * 64) ((unsigned*)(ws + WS_BAR))[i] = 0u;
        bf16_t* U = (bf16_t*)(ws + WS_U);
        for (int m = gw; m < MTOK; m += 2 * NGW) {
            const int m2 = m + NGW; const f32x4* xa = (const f32x4*)(x_in + (size_t)m * DM) + lane; const f32x4* xb = (const f32x4*)(x_in + (size_t)m2 * DM) + lane;
            f32x4 va[8], vb[8]; float sa = 0.f, sb = 0.f;
#pragma unroll
            for (int j = 0; j < 8; ++j) va[j] = xa[64 * j];
#pragma unroll
            for (int j = 0; j < 8; ++j) vb[j] = xb[64 * j];
#pragma unroll
            for (int j = 0; j < 8; ++j) { sa += (va[j].x * va[j].x + va[j].y * va[j].y) + (va[j].z * va[j].z + va[j].w * va[j].w); sb += (vb[j].x * vb[j].x + vb[j].y * vb[j].y) + (vb[j].z * vb[j].z + vb[j].w * vb[j].w); }
            const float ra = 1.0f / sqrtf(wave_sum(sa) * (1.f / DM) + EPS), rb = 1.0f / sqrtf(wave_sum(sb) * (1.f / DM) + EPS);
            u32x2* oa = (u32x2*)(U + (size_t)m * DM) + lane; u32x2* ob = (u32x2*)(U + (size_t)m2 * DM) + lane;
#pragma unroll
            for (int j = 0; j < 8; ++j) { const f32x4 g = ((const f32x4*)a.in[1])[lane + 64 * j];
                u32x2 w; w.x = cvtpk(va[j].x * ra * g.x, va[j].y * ra * g.y); w.y = cvtpk(va[j].z * ra * g.z, va[j].w * ra * g.w); oa[64 * j] = w;
                w.x = cvtpk(vb[j].x * rb * g.x, vb[j].y * rb * g.y); w.y = cvtpk(vb[j].z * rb * g.z, vb[j].w * rb * g.w); ob[64 * j] = w; }
        }
    }
    grid.sync();
    const XcdBarrier xbar = xcd_barrier_post((unsigned*)(ws + WS_BAR), MISC + 8);
    for (int t = gw; t < SG * (NCH - 1); t += NGW) s5_task<false>(a, t % SG, t / SG, lds + wave * 10240, lane);
    xcd_barrier(xbar);
    for (int t = gw; t < SG * NCH; t += NGW) s5_task<true>(a, t % SG, t / SG, lds + wave * 10240, lane);
    xcd_barrier(xbar);
    { pg8::Gemm g{XN, Wglu, MTOK, 2 * DM, DM}; pg8::StaticOrder S; S.init(MTOK, 2 * DM, G, bx); pg8::EpiGluRes2 E{x_in, X1, RS1, DM};
      pg8::gemm_phase<pg8::EpiGluRes2, pg8::StaticOrder, true, true>(lds, g, S, E); }
    xcd_barrier(xbar);
    { pg8::Gemm g{X1, Wgu0, MTOK, 2 * DFF, DM}; pg8::StaticOrder S; S.init(MTOK, 2 * DFF, G, bx); pg8::EpiSwiglu2 E{HB, DFF, RS1, 1.f / DM, EPS};
      pg8::gemm_phase<pg8::EpiSwiglu2, pg8::StaticOrder, true, true>(lds, g, S, E); }
    xcd_barrier(xbar);
    { pg8::Gemm g{HB, Wd0, MTOK, DM, DFF}; pg8::StaticOrder S; S.init(MTOK, DM, G, bx); pg8::EpiResAddBf E{X1, XN, RS2, DM};
      pg8::gemm_phase<pg8::EpiResAddBf, pg8::StaticOrder, true, true>(lds, g, S, E); }
    xcd_barrier(xbar);
    { pg8::Gemm g{XN, Wqkv, MTOK, 5 * DM, DM}; pg8::StaticOrder S; S.init(MTOK, 5 * DM, G, bx); pg8::EpiQKV E{Q0, QKV_T, SEQ, HP, RS2, 1.f / DM, EPS, (PG8_LAS float*)(lds + LDS_STG), a.in[14]};
      pg8::gemm_phase<pg8::EpiQKV, pg8::StaticOrder, true, true>(lds, g, S, E); }
    xcd_barrier(xbar);
    for (int su = vcu; su < BATCH * NHEAD * (SEQ / 2048); su += G) {
        const int b = su / (NHEAD * 8), head = (su / 8) % NHEAD, Ts = (su % 8) * 2048;
        attn_shared(a, b, head, Ts, wave, lds, lane);
        __syncthreads();
    }
    xcd_barrier(xbar);
    { pg8::Gemm g{X1, Wo, MTOK, DM, DM}; pg8::StaticOrder S; S.init(MTOK, DM, G, bx); pg8::EpiResAddBf E{XN, XN, RS3, DM};
      pg8::gemm_phase<pg8::EpiResAddBf, pg8::StaticOrder, true, true>(lds, g, S, E); }
    xcd_barrier(xbar);
    { pg8::Gemm g{XN, Wgu1, MTOK, 2 * DFF, DM}; pg8::StaticOrder S; S.init(MTOK, 2 * DFF, G, bx); pg8::EpiSwiglu2 E{HB, DFF, RS3, 1.f / DM, EPS};
      pg8::gemm_phase<pg8::EpiSwiglu2, pg8::StaticOrder, true, true>(lds, g, S, E); }
    xcd_barrier(xbar);
    { pg8::Gemm g{HB, Wd1, MTOK, DM, DFF}; pg8::StaticOrder S; S.init(MTOK, DM, G, bx); pg8::EpiResAddF32 E{XN, xo, DM};
      pg8::gemm_phase<pg8::EpiResAddF32, pg8::StaticOrder, true, true>(lds, g, S, E); }
}

extern "C" void kernel_launch(void* const* d_in, const int* in_sizes, int n_in, void* d_out, int out_size, void* d_ws, size_t ws_size, hipStream_t stream) {
    static int grid = 0;
    if (grid == 0) {
        if (n_in != 20 || out_size != MTOK * DM || ws_size < WS_END) { fprintf(stderr, "kernel_launch: unexpected problem (n_in %d out %d ws %zu)\n", n_in, out_size, ws_size); grid = -1; return; }
        int dev = 0, cus = 0, per_cu = 0;
        hipGetDevice(&dev); hipDeviceGetAttribute(&cus, hipDeviceAttributeMultiprocessorCount, dev);
        if (hipFuncSetAttribute((const void*)mega_fwd, hipFuncAttributeMaxDynamicSharedMemorySize, LDS_BYTES) != hipSuccess) { fprintf(stderr, "kernel_launch: hipFuncSetAttribute failed\n"); grid = -1; return; }
        if (hipOccupancyMaxActiveBlocksPerMultiprocessor(&per_cu, (const void*)mega_fwd, NWAVES * 64, LDS_BYTES) != hipSuccess || per_cu < 1) { fprintf(stderr, "kernel_launch: occupancy query says %d\n", per_cu); per_cu = 1; }
        (void)hipGetLastError();
        grid = cus * 1;
    }
    if (grid < 0) return;
    Args a{};
    for (int i = 0; i < 20; ++i) a.in[i] = (const float*)d_in[i];
    a.out = (float*)d_out; a.ws = (unsigned char*)d_ws;
    void* args[] = {&a};
    hipError_t e = hipLaunchCooperativeKernel((const void*)mega_fwd, dim3(grid), dim3(NWAVES * 64), args, LDS_BYTES, stream);
    if (e != hipSuccess) fprintf(stderr, "kernel_launch: cooperative launch failed: %s (grid %d)\n", hipGetErrorString(e), grid);
}
```
